# Optimizing an MI355X kernel written in HIP

```python
import math
import jax, jax.numpy as jnp
from jax import lax
import numpy as np

D_MODEL = 4096
BATCH = 1
SEQ = 16384
DEPTH = 2
DEC_BATCH = 8
DEC_SEQ = 64
PAST_LEN = 4096

CHUNK = 64
MIX_WIDTH = D_MODEL
CONV_WIDTH = MIX_WIDTH // 2
SSM_WIDTH = MIX_WIDTH - CONV_WIDTH
SSM_GROUP = 16
SSM_GROUPS = SSM_WIDTH // SSM_GROUP
SSM_STATE = 64
CONV_K = 3
D_FF = 11008
LN_EPS = 1e-5
DEEPNORM_ALPHA = (2 * DEPTH) ** 0.25
DEEPNORM_BETA = (8 * DEPTH) ** -0.25
DT_MIN = 1e-3
DT_MAX = 1e-1

kernel_name = "hybrid_shortconv_s5_convffn_deepnorm_step"


def layer_norm(x, g, b):
    xf = x.astype(jnp.float32)
    mu = jnp.mean(xf, axis=-1, keepdims=True)
    var = jnp.mean(jnp.square(xf - mu), axis=-1, keepdims=True)
    y = (xf - mu) * lax.rsqrt(var + LN_EPS) * g.astype(jnp.float32) + b.astype(jnp.float32)
    return y.astype(x.dtype)


def causal_dwconv(x, prev, w):
    T = x.shape[1]
    xp = jnp.concatenate([prev.astype(x.dtype), x], axis=1)
    y = xp[:, 0:T] * w[0]
    for k in range(1, CONV_K):
        y = y + xp[:, k:k + T] * w[k]
    return y, xp[:, T:]


def cmul(ar, ai, br, bi):
    return ar * br - ai * bi, ar * bi + ai * br


def s5_discretise(a_re, a_im, log_dt, b_re, b_im):
    a_re = a_re.astype(jnp.float32)
    a_im = a_im.astype(jnp.float32)
    dt = jnp.exp(log_dt.astype(jnp.float32))[:, None]
    mag = jnp.exp(a_re * dt)
    lb_re = mag * jnp.cos(a_im * dt)
    lb_im = mag * jnp.sin(a_im * dt)
    nr, ni = lb_re - 1.0, lb_im
    den = a_re * a_re + a_im * a_im
    coef_re = (nr * a_re + ni * a_im) / den
    coef_im = (ni * a_re - nr * a_im) / den
    bb_re, bb_im = cmul(coef_re[..., None], coef_im[..., None],
                        b_re.astype(jnp.float32), b_im.astype(jnp.float32))
    return lb_re, lb_im, bb_re, bb_im


def _scan_combine(e1, e2):
    a1r, a1i, b1r, b1i = e1
    a2r, a2i, b2r, b2i = e2
    ar, ai = cmul(a2r, a2i, a1r, a1i)
    br, bi = cmul(a2r, a2i, b1r, b1i)
    return ar, ai, br + b2r, bi + b2i


def s5_mixer(u, h0_re, h0_im, a_re, a_im, log_dt, b_re, b_im, c_re, c_im, d_skip, w_glu):
    bsz, T, _ = u.shape
    uf = u.astype(jnp.float32)
    lb_re, lb_im, bb_re, bb_im = s5_discretise(a_re, a_im, log_dt, b_re, b_im)
    c_re = c_re.astype(jnp.float32)
    c_im = c_im.astype(jnp.float32)
    ch = min(T, CHUNK)
    n = T // ch
    uc = uf.reshape(bsz, n, ch, SSM_GROUPS, SSM_GROUP).transpose(1, 0, 2, 3, 4)
    a_r = jnp.broadcast_to(lb_re, (bsz, ch, SSM_GROUPS, SSM_STATE))
    a_i = jnp.broadcast_to(lb_im, (bsz, ch, SSM_GROUPS, SSM_STATE))

    def chunk_step(carry, u_blk):
        hr, hi = carry
        bu_r = jnp.einsum('gpc,btgc->btgp', bb_re, u_blk)
        bu_i = jnp.einsum('gpc,btgc->btgp', bb_im, u_blk)
        pr, pi, sr, si = lax.associative_scan(_scan_combine, (a_r, a_i, bu_r, bu_i), axis=1)
        fr, fi = cmul(pr, pi, hr[:, None], hi[:, None])
        hs_r, hs_i = sr + fr, si + fi
        y = (jnp.einsum('gcp,btgp->btgc', c_re, hs_r)
             - jnp.einsum('gcp,btgp->btgc', c_im, hs_i))
        return (hs_r[:, -1], hs_i[:, -1]), y

    (hr, hi), ys = lax.scan(chunk_step,
                            (h0_re.astype(jnp.float32), h0_im.astype(jnp.float32)), uc)
    y = ys.transpose(1, 0, 2, 3, 4).reshape(bsz, T, SSM_WIDTH) + d_skip.astype(jnp.float32) * uf
    g = jax.nn.gelu(y)
    yb = g * jax.nn.sigmoid(g @ w_glu.astype(jnp.float32))
    return yb.astype(u.dtype), hr, hi


def hybrid_layer(x, prev_conv, prev_re, prev_im, prev_ffn,
                 w_in, conv_w, a_re, a_im, log_dt, b_re, b_im, c_re, c_im, d_skip, w_glu,
                 w_out, ln1_g, ln1_b, w_ffn_a, w_ffn_v, ffn_conv_w, w_ffn_down, ln2_g, ln2_b):
    proj = x @ w_in
    b_gate = proj[..., 0:CONV_WIDTH]
    c_gate = proj[..., CONV_WIDTH:2 * CONV_WIDTH]
    h = proj[..., 2 * CONV_WIDTH:3 * CONV_WIDTH]
    u = proj[..., 3 * CONV_WIDTH:]
    conv_out, new_conv = causal_dwconv(c_gate * h, prev_conv, conv_w)
    ya = b_gate * conv_out
    yb, new_re, new_im = s5_mixer(u, prev_re, prev_im, a_re, a_im, log_dt,
                                  b_re, b_im, c_re, c_im, d_skip, w_glu)
    mix = jnp.concatenate([ya, yb], axis=-1) @ w_out
    x = layer_norm(DEEPNORM_ALPHA * x + mix, ln1_g, ln1_b)
    a, new_ffn = causal_dwconv(x @ w_ffn_a, prev_ffn, ffn_conv_w)
    f = (jax.nn.silu(a) * (x @ w_ffn_v)) @ w_ffn_down
    x = layer_norm(DEEPNORM_ALPHA * x + f, ln2_g, ln2_b)
    return x, new_conv, new_re, new_im, new_ffn


def setup_inputs(seed: int = 0) -> dict:
    key = jax.random.key(seed)
    ks = jax.random.split(key, 32)
    f32 = jnp.float32
    nrm = lambda k, shape, s: jax.random.normal(k, shape, f32) * s
    L = DEPTH
    G, P, Cg = SSM_GROUPS, SSM_STATE, SSM_GROUP
    inp = {}
    inp['x_prompt'] = nrm(ks[0], (BATCH, SEQ, D_MODEL), 1.0)
    inp['x_sample'] = nrm(ks[1], (DEC_BATCH, DEC_SEQ, D_MODEL), 1.0)
    inp['state_conv'] = nrm(ks[2], (L, DEC_BATCH, CONV_K - 1, CONV_WIDTH), 1.0)
    inp['state_ssm_re'] = nrm(ks[3], (L, DEC_BATCH, G, P), 0.5)
    inp['state_ssm_im'] = nrm(ks[4], (L, DEC_BATCH, G, P), 0.5)
    inp['state_ffn_conv'] = nrm(ks[5], (L, DEC_BATCH, CONV_K - 1, D_FF), 1.0)
    inp['w_in'] = nrm(ks[6], (L, D_MODEL, 3 * CONV_WIDTH + SSM_WIDTH), D_MODEL ** -0.5)
    inp['conv_w'] = nrm(ks[7], (L, CONV_K, CONV_WIDTH), CONV_K ** -0.5)
    inp['ssm_a_re'] = -0.5 + nrm(ks[8], (L, G, P), 0.01)
    inp['ssm_a_im'] = math.pi * jnp.arange(P, dtype=f32)[None, None, :] + nrm(ks[9], (L, G, P), 0.01)
    inp['ssm_log_dt'] = jax.random.uniform(ks[10], (L, G), f32, math.log(DT_MIN), math.log(DT_MAX))
    inp['ssm_b_re'] = nrm(ks[11], (L, G, P, Cg), (2 * Cg) ** -0.5)
    inp['ssm_b_im'] = nrm(ks[12], (L, G, P, Cg), (2 * Cg) ** -0.5)
    inp['ssm_c_re'] = nrm(ks[13], (L, G, Cg, P), (2 * P) ** -0.5)
    inp['ssm_c_im'] = nrm(ks[14], (L, G, Cg, P), (2 * P) ** -0.5)
    inp['ssm_d'] = nrm(ks[15], (L, SSM_WIDTH), 0.5)
    inp['w_glu'] = nrm(ks[16], (L, SSM_WIDTH, SSM_WIDTH), SSM_WIDTH ** -0.5)
    inp['w_out'] = nrm(ks[17], (L, MIX_WIDTH, D_MODEL), DEEPNORM_BETA * MIX_WIDTH ** -0.5)
    inp['ln1_g'] = 1.0 + nrm(ks[18], (L, D_MODEL), 0.01)
    inp['ln1_b'] = nrm(ks[19], (L, D_MODEL), 0.01)
    inp['w_ffn_a'] = nrm(ks[20], (L, D_MODEL, D_FF), D_MODEL ** -0.5)
    inp['w_ffn_v'] = nrm(ks[21], (L, D_MODEL, D_FF), D_MODEL ** -0.5)
    inp['ffn_conv_w'] = nrm(ks[22], (L, CONV_K, D_FF), CONV_K ** -0.5)
    inp['w_ffn_down'] = nrm(ks[23], (L, D_FF, D_MODEL), DEEPNORM_BETA * D_FF ** -0.5)
    inp['ln2_g'] = 1.0 + nrm(ks[24], (L, D_MODEL), 0.01)
    inp['ln2_b'] = nrm(ks[25], (L, D_MODEL), 0.01)
    return inp


def reference(x_prompt, x_sample, state_conv, state_ssm_re, state_ssm_im, state_ffn_conv,
              w_in, conv_w, ssm_a_re, ssm_a_im, ssm_log_dt, ssm_b_re, ssm_b_im, ssm_c_re, ssm_c_im,
              ssm_d, w_glu, w_out, ln1_g, ln1_b, w_ffn_a, w_ffn_v, ffn_conv_w, w_ffn_down,
              ln2_g, ln2_b):
    bp = x_prompt.shape[0]
    xp, xs = x_prompt, x_sample
    pc, pr, pi, pf = [], [], [], []
    sc, sr, si, sf = [], [], [], []
    for l in range(DEPTH):
        weights = (w_in[l], conv_w[l], ssm_a_re[l], ssm_a_im[l], ssm_log_dt[l], ssm_b_re[l],
                   ssm_b_im[l], ssm_c_re[l], ssm_c_im[l], ssm_d[l], w_glu[l], w_out[l],
                   ln1_g[l], ln1_b[l], w_ffn_a[l], w_ffn_v[l], ffn_conv_w[l], w_ffn_down[l],
                   ln2_g[l], ln2_b[l])
        zc = jnp.zeros((bp, CONV_K - 1, CONV_WIDTH), xp.dtype)
        zs = jnp.zeros((bp, SSM_GROUPS, SSM_STATE), jnp.float32)
        zf = jnp.zeros((bp, CONV_K - 1, D_FF), xp.dtype)
        xp, c1, r1, i1, f1 = hybrid_layer(xp, zc, zs, zs, zf, *weights)
        pc.append(c1); pr.append(r1); pi.append(i1); pf.append(f1)
        xs, c2, r2, i2, f2 = hybrid_layer(xs, state_conv[l], state_ssm_re[l], state_ssm_im[l],
                                          state_ffn_conv[l], *weights)
        sc.append(c2); sr.append(r2); si.append(i2); sf.append(f2)
    new_conv_p = jnp.stack(pc)
    new_ssm_re_p = jnp.stack(pr)
    new_ssm_im_p = jnp.stack(pi)
    new_ffn_p = jnp.stack(pf)
    new_conv_s = jnp.stack(sc)
    new_ssm_re_s = jnp.stack(sr)
    new_ssm_im_s = jnp.stack(si)
    new_ffn_s = jnp.stack(sf)
    return (xp, xs, new_conv_p, new_ssm_re_p, new_ssm_im_p, new_ffn_p,
            new_conv_s, new_ssm_re_s, new_ssm_im_s, new_ffn_s)
```

```cpp
#include <hip/hip_runtime.h>
#include <cstdio>
#include <cstdint>
namespace pg8 {
#define PG8_LAS __attribute__((address_space(3)))
typedef unsigned short bf16_t;
typedef short bf16x8 __attribute__((ext_vector_type(8)));
typedef float f32x4 __attribute__((ext_vector_type(4)));
typedef unsigned u32x4 __attribute__((ext_vector_type(4)));
typedef unsigned u32x2 __attribute__((ext_vector_type(2)));
constexpr int BM = 256, BK = 64, HALF = 128, HTB = HALF * BK * 2  , STAGE_BYTES = 8 * HTB, NXCD = 8, WGM = 8;

__host__ __device__ __forceinline__ int lds_byte(int r, int c) { const int st = (r >> 4) * 2 + (c >> 5), rr = r & 15, cc = c & 31, ob = rr * 64 + cc * 2; return st * 1024 + (ob ^ (((ob >> 9) & 1) << 5)); }
__host__ __device__ __forceinline__ void stage_rc(int b, int& R, int& C) { const int st = b / 1024, sb = b % 1024, swz = sb ^ (((sb >> 9) & 1) << 5); R = (st >> 1) * 16 + swz / 64; C = (st & 1) * 32 + (swz % 64) / 2; }
__host__ __device__ __forceinline__ int perm32(int rho) { const int n = rho >> 4, i = rho & 15; return 8 * (i >> 2) + 4 * n + (i & 3); }

struct Unit { int pm, pn, k0, nt, slab; };
struct Gemm { const bf16_t* A; const bf16_t* Bt; int M, N, K; };

struct StaticOrder {
    int nM, nN, nwg, G, c, ntk, wgm = WGM;
    __host__ __device__ void init(int M, int N, int G_, int c_, int K_) { nM = M / BM; nN = N / BM; nwg = nM * nN; G = G_; c = c_; ntk = K_ / BK; }
    __host__ __device__ bool next(int i, Unit& u) const { return at((long)i * G + c, u); }
    __host__ __device__ bool at(long L, Unit& u) const {
        if (L >= nwg) return false;
        int wgid = (int)L; { const int q = nwg / NXCD, r = nwg % NXCD, xcd = wgid % NXCD, off = wgid / NXCD; wgid = (xcd < r ? xcd * (q + 1) : r * (q + 1) + (xcd - r) * q) + off; }
        const int nig = wgm * nN, gid = wgid / nig, fm = gid * wgm, gsz = (nM - fm) < wgm ? (nM - fm) : wgm;
        u.pm = fm + ((wgid % nig) % gsz); u.pn = (wgid % nig) / gsz; u.k0 = 0; u.nt = ntk; u.slab = -1; return true;
    }
    __device__ __forceinline__ void a_ready(const Unit&) const {}
    __device__ __forceinline__ void done(const Unit&) const {}
};
struct TwoPartOrder {
    StaticOrder full, rest; int nwg, G, c; bool two;
    __host__ __device__ void init(int M, int Mfull, int N, int G_, int c_, int K_) { full.init(Mfull, N, G_, c_, K_); rest.init(M - Mfull, N, G_, c_, K_); G = G_; c = c_; nwg = full.nwg + rest.nwg;
        two = (full.nwg % NXCD == 0); if (!two) { full.init(M, N, G_, c_, K_); rest.nwg = 0; } }
    __host__ __device__ bool next(int i, Unit& u) const {
        const long L = (long)i * G + c;
        if (L < full.nwg) return full.at(L, u);
        if (!rest.at(L - full.nwg, u)) return false;
        u.pm += full.nM; return true;
    }
    __device__ __forceinline__ void a_ready(const Unit&) const {}
    __device__ __forceinline__ void done(const Unit&) const {}
};
struct SplitOrder {
    StaticOrder full, all; int nfr, nN, G, c, ntk; bool split;
    static constexpr int NSPLIT = 8;
    __host__ __device__ void init(int M, int Mfull, int N, int G_, int c_, int K_) { full.init(Mfull, N, G_, c_, K_); all.init(M, N, G_, c_, K_); nN = N / BM; G = G_; c = c_; ntk = K_ / BK;
        nfr = full.nwg / G_; split = (full.nwg % G_ == 0) && (((M - Mfull) / BM) * nN * NSPLIT == G_) && (ntk / 2 >= NSPLIT); }
    __host__ __device__ bool next(int i, Unit& u) const {
        if (!split) return all.next(i, u);
        if (i < nfr) return full.next(i, u);
        if (i > nfr) return false;
        const int e = c / NSPLIT, sp = c % NSPLIT, pairs = ntk / 2, base = pairs / NSPLIT, rem = pairs % NSPLIT;
        u.pm = full.nM + e / nN; u.pn = e % nN; u.k0 = 2 * (sp * base + (sp < rem ? sp : rem)); u.nt = 2 * (base + (sp < rem ? 1 : 0)); u.slab = sp; return true;
    }
    __device__ __forceinline__ void a_ready(const Unit&) const {}
    __device__ __forceinline__ void done(const Unit&) const {}
};

__device__ __forceinline__ unsigned cvt_pk_bf16(float lo, float hi) { unsigned r; asm volatile("v_cvt_pk_bf16_f32 %0, %1, %2" : "=v"(r) : "v"(lo), "v"(hi)); return r; }
typedef float f32x2 __attribute__((ext_vector_type(2)));
__device__ __forceinline__ float bflo(unsigned w) { return __uint_as_float(w << 16); }
__device__ __forceinline__ float bfhi(unsigned w) { return __uint_as_float(w & 0xffff0000u); }
__device__ __forceinline__ float sigmoidf_(float x) { return __builtin_amdgcn_rcpf(1.0f + __expf(-x)); }

struct EpiBf16 {
    static constexpr bool PERM = true, AFTER_DRAIN = false;
    bf16_t* O; int ldc; int split_cols; size_t split_stride;
    __device__ __forceinline__ void operator()(const f32x4 (&acc)[2][2][4][2], const Unit& u, int wr, int wc, int fr, int fq) const {
        const int row0 = u.pm * BM + wr * 64 + fr; int colt = u.pn * BM; bf16_t* base = O;
        if (split_cols) { const int t = colt / split_cols; base += (size_t)t * split_stride; colt -= t * split_cols; }
        const int col0 = colt + wc * 32 + 8 * fq;
#pragma unroll
        for (int ai = 0; ai < 2; ++ai)
#pragma unroll
            for (int m = 0; m < 4; ++m) { bf16_t* rowp = base + (size_t)(row0 + ai * HALF + m * 16) * ldc + col0;
#pragma unroll
                for (int bj = 0; bj < 2; ++bj) { const f32x4 v0 = acc[ai][bj][m][0], v1 = acc[ai][bj][m][1];
                    u32x4 w; w.x = cvt_pk_bf16(v0[0], v0[1]); w.y = cvt_pk_bf16(v0[2], v0[3]); w.z = cvt_pk_bf16(v1[0], v1[1]); w.w = cvt_pk_bf16(v1[2], v1[3]);
                    *(u32x4*)(rowp + bj * HALF) = w; } }
    }
};

__device__ __forceinline__ float dpp_ror1(float x) { return __int_as_float(__builtin_amdgcn_update_dpp(0, __float_as_int(x), 0x121, 0xF, 0xF, true)); }
__device__ __forceinline__ float dpp_ror2(float x) { return __int_as_float(__builtin_amdgcn_update_dpp(0, __float_as_int(x), 0x122, 0xF, 0xF, true)); }
struct EpiGate {
    static constexpr bool PERM = true, AFTER_DRAIN = false;
    bf16_t* HG; int ldh; const float* cw; bf16_t* side;
    __device__ __forceinline__ void operator()(const f32x4 (&acc)[2][2][4][2], const Unit& u, int wr, int wc, int fr, int fq) const {
        const int ch0 = u.pn * 128 + wc * 32 + 8 * fq;
        f32x4 w0[2], w1[2], w2[2];
#pragma unroll
        for (int n = 0; n < 2; ++n) { w0[n] = *(const f32x4*)(cw + ch0 + 4 * n); w1[n] = *(const f32x4*)(cw + ldh + ch0 + 4 * n); w2[n] = *(const f32x4*)(cw + 2 * ldh + ch0 + 4 * n); }
        const bool f1 = fr >= 1, f2 = fr >= 2;
#pragma unroll
        for (int ai = 0; ai < 2; ++ai) {
            const int blk = u.pm * 4 + ai * 2 + wr;
#pragma unroll
            for (int m = 0; m < 4; ++m) {
                const size_t row = (size_t)(u.pm * BM + ai * HALF + wr * 64 + m * 16 + fr);
                float hg[8];
#pragma unroll
                for (int n = 0; n < 2; ++n)
#pragma unroll
                    for (int i = 0; i < 4; ++i) {
                        const float cur = acc[ai][0][m][n][i], prv = (m > 0) ? acc[ai][0][m > 0 ? m - 1 : 0][n][i] : cur;
                        const float r1c = dpp_ror1(cur), r1p = dpp_ror1(prv), r2c = dpp_ror2(cur), r2p = dpp_ror2(prv);
                        const float tm1 = f1 ? r1c : r1p, tm2 = f2 ? r2c : r2p;
                        const float cv = w0[n][i] * tm2 + w1[n][i] * tm1 + w2[n][i] * cur;
                        hg[4 * n + i] = cv * sigmoidf_(cv) * acc[ai][1][m][n][i];
                    }
                if (m == 0 && fr < 2) {
                    const f32x4 a0 = acc[ai][0][0][0], a1 = acc[ai][0][0][1], v0 = acc[ai][1][0][0], v1 = acc[ai][1][0][1];
                    u32x4 wa, wv; wa.x = cvt_pk_bf16(a0[0], a0[1]); wa.y = cvt_pk_bf16(a0[2], a0[3]); wa.z = cvt_pk_bf16(a1[0], a1[1]); wa.w = cvt_pk_bf16(a1[2], a1[3]);
                    wv.x = cvt_pk_bf16(v0[0], v0[1]); wv.y = cvt_pk_bf16(v0[2], v0[3]); wv.z = cvt_pk_bf16(v1[0], v1[1]); wv.w = cvt_pk_bf16(v1[2], v1[3]);
                    *(u32x4*)(side + ((size_t)blk * 6 + 2 + fr) * ldh + ch0) = wa; *(u32x4*)(side + ((size_t)blk * 6 + 4 + fr) * ldh + ch0) = wv;
                } else {
                    u32x4 w; w.x = cvt_pk_bf16(hg[0], hg[1]); w.y = cvt_pk_bf16(hg[2], hg[3]); w.z = cvt_pk_bf16(hg[4], hg[5]); w.w = cvt_pk_bf16(hg[6], hg[7]);
                    *(u32x4*)(HG + row * ldh + ch0) = w;
                }
                if (m == 3 && fr >= 14) {
                    const f32x4 a0 = acc[ai][0][3][0], a1 = acc[ai][0][3][1];
                    u32x4 wa; wa.x = cvt_pk_bf16(a0[0], a0[1]); wa.y = cvt_pk_bf16(a0[2], a0[3]); wa.z = cvt_pk_bf16(a1[0], a1[1]); wa.w = cvt_pk_bf16(a1[2], a1[3]);
                    *(u32x4*)(side + ((size_t)blk * 6 + (fr - 14)) * ldh + ch0) = wa;
                }
            }
        }
    }
};


struct EpiMix {
    static constexpr bool PERM = true, AFTER_DRAIN = false;
    bf16_t* MX; int ldm; bf16_t* U; int ldu; const float* cw; int ldw; float* side;
    __device__ __forceinline__ void operator()(const f32x4 (&acc)[2][2][4][2], const Unit& u, int wr, int wc, int fr, int fq) const {
        const int ch0 = u.pn * 64 + wc * 16 + 4 * fq;
        const f32x4 w0 = *(const f32x4*)(cw + ch0), w1 = *(const f32x4*)(cw + ldw + ch0), w2 = *(const f32x4*)(cw + 2 * ldw + ch0);
        const bool f1 = fr >= 1, f2 = fr >= 2;
#pragma unroll
        for (int ai = 0; ai < 2; ++ai) {
            const int blk = u.pm * 4 + ai * 2 + wr;
            f32x4 zp = {0.f, 0.f, 0.f, 0.f};
#pragma unroll
            for (int m = 0; m < 4; ++m) {
                const size_t row = (size_t)(u.pm * BM + ai * HALF + wr * 64 + m * 16 + fr);
                const f32x4 z = acc[ai][0][m][1] * acc[ai][1][m][0];
                f32x4 ya;
#pragma unroll
                for (int i = 0; i < 4; ++i) {
                    const float r1c = dpp_ror1(z[i]), r1p = dpp_ror1(zp[i]), r2c = dpp_ror2(z[i]), r2p = dpp_ror2(zp[i]);
                    const float tm1 = f1 ? r1c : r1p, tm2 = f2 ? r2c : r2p;
                    ya[i] = acc[ai][0][m][0][i] * (w0[i] * tm2 + w1[i] * tm1 + w2[i] * z[i]);
                }
                if (m == 0 && fr < 2) { *(f32x4*)(side + ((size_t)blk * 6 + 2 + fr) * ldu + ch0) = z; *(f32x4*)(side + ((size_t)blk * 6 + 4 + fr) * ldu + ch0) = acc[ai][0][0][0]; }
                else { u32x2 w; w.x = cvt_pk_bf16(ya[0], ya[1]); w.y = cvt_pk_bf16(ya[2], ya[3]); *(u32x2*)(MX + row * ldm + ch0) = w; }
                if (m == 3 && fr >= 14) *(f32x4*)(side + ((size_t)blk * 6 + (fr - 14)) * ldu + ch0) = z;
                { const f32x4 uu = acc[ai][1][m][1]; u32x2 w; w.x = cvt_pk_bf16(uu[0], uu[1]); w.y = cvt_pk_bf16(uu[2], uu[3]); *(u32x2*)(U + row * ldu + ch0) = w; }
                zp = z;
            }
        }
    }
};

struct EpiGlu {
    static constexpr bool PERM = true, AFTER_DRAIN = false;
    const bf16_t* Gb; int ldg; bf16_t* O; int ldc; int ocol0;
    __device__ __forceinline__ void operator()(const f32x4 (&acc)[2][2][4][2], const Unit& u, int wr, int wc, int fr, int fq) const {
        const int row0 = u.pm * BM + wr * 64 + fr; const int col0 = u.pn * BM + wc * 32 + 8 * fq;
#pragma unroll
        for (int ai = 0; ai < 2; ++ai) {
            u32x4 gv[4][2];
#pragma unroll
            for (int m = 0; m < 4; ++m)
#pragma unroll
                for (int bj = 0; bj < 2; ++bj) gv[m][bj] = *(const u32x4*)(Gb + (size_t)(row0 + ai * HALF + m * 16) * ldg + col0 + bj * HALF);
            asm volatile("" : "+v"(gv[0][0]), "+v"(gv[0][1]), "+v"(gv[1][0]), "+v"(gv[1][1]), "+v"(gv[2][0]), "+v"(gv[2][1]), "+v"(gv[3][0]), "+v"(gv[3][1]));
#pragma unroll
            for (int m = 0; m < 4; ++m) { const size_t row = (size_t)(row0 + ai * HALF + m * 16);
#pragma unroll
                for (int bj = 0; bj < 2; ++bj) { const f32x4 v0 = acc[ai][bj][m][0], v1 = acc[ai][bj][m][1];
                    const u32x4 gq = gv[m][bj];
                    u32x4 w;
                    w.x = cvt_pk_bf16(bflo(gq.x) * sigmoidf_(v0[0]), bfhi(gq.x) * sigmoidf_(v0[1]));
                    w.y = cvt_pk_bf16(bflo(gq.y) * sigmoidf_(v0[2]), bfhi(gq.y) * sigmoidf_(v0[3]));
                    w.z = cvt_pk_bf16(bflo(gq.z) * sigmoidf_(v1[0]), bfhi(gq.z) * sigmoidf_(v1[1]));
                    w.w = cvt_pk_bf16(bflo(gq.w) * sigmoidf_(v1[2]), bfhi(gq.w) * sigmoidf_(v1[3]));
                    *(u32x4*)(O + row * ldc + ocol0 + col0 + bj * HALF) = w; } }
        }
    }
};
struct EpiRes {
    static constexpr bool PERM = true, AFTER_DRAIN = false;
    const float* resA; const float* resB; const bf16_t* resH; int split_row; bf16_t* out; int ldc; float alpha; float* slabs; size_t slab_stride;
    __device__ __forceinline__ void operator()(const f32x4 (&acc)[2][2][4][2], const Unit& u, int wr, int wc, int fr, int fq) const {
        const int row0 = u.pm * BM + wr * 64 + fr, col0 = u.pn * BM + wc * 32 + 8 * fq;
        if (u.slab >= 0) {
            float* sb = slabs + (size_t)u.slab * slab_stride + (size_t)(row0 - split_row) * ldc + col0;
#pragma unroll
            for (int ai = 0; ai < 2; ++ai)
#pragma unroll
                for (int m = 0; m < 4; ++m)
#pragma unroll
                    for (int bj = 0; bj < 2; ++bj)
#pragma unroll
                        for (int n = 0; n < 2; ++n) *(f32x4*)(sb + (size_t)(ai * HALF + m * 16) * ldc + bj * HALF + 4 * n) = acc[ai][bj][m][n];
            return;
        }
        bf16_t* ob = out + (size_t)row0 * ldc + col0;
        if (resH != nullptr) {
            const bf16_t* hb = resH + (size_t)row0 * ldc + col0;
#pragma unroll
            for (int ai = 0; ai < 2; ++ai) {
                u32x4 hq[4][2];
#pragma unroll
                for (int m = 0; m < 4; ++m)
#pragma unroll
                    for (int bj = 0; bj < 2; ++bj) hq[m][bj] = *(const u32x4*)(hb + (size_t)(ai * HALF + m * 16) * ldc + bj * HALF);
                asm volatile("" : "+v"(hq[0][0]), "+v"(hq[0][1]), "+v"(hq[1][0]), "+v"(hq[1][1]), "+v"(hq[2][0]), "+v"(hq[2][1]), "+v"(hq[3][0]), "+v"(hq[3][1]));
#pragma unroll
                for (int m = 0; m < 4; ++m) { const size_t ro = (size_t)(ai * HALF + m * 16) * ldc;
#pragma unroll
                    for (int bj = 0; bj < 2; ++bj) { const u32x4 hv = hq[m][bj];
                        const f32x4 r0 = {bflo(hv.x), bfhi(hv.x), bflo(hv.y), bfhi(hv.y)}, r1 = {bflo(hv.z), bfhi(hv.z), bflo(hv.w), bfhi(hv.w)};
                        const f32x4 o0 = r0 * alpha + acc[ai][bj][m][0], o1 = r1 * alpha + acc[ai][bj][m][1];
                        u32x4 w; w.x = cvt_pk_bf16(o0[0], o0[1]); w.y = cvt_pk_bf16(o0[2], o0[3]); w.z = cvt_pk_bf16(o1[0], o1[1]); w.w = cvt_pk_bf16(o1[2], o1[3]);
                        *(u32x4*)(ob + ro + bj * HALF) = w; } }
            }
            return;
        }
        const float* rbase = ((u.pm * BM < split_row) ? resA + (size_t)row0 * ldc : resB + (size_t)(row0 - split_row) * ldc) + col0;
#pragma unroll
        for (int ai = 0; ai < 2; ++ai)
#pragma unroll
            for (int mh = 0; mh < 2; ++mh) {
                f32x4 rq[2][2][2];
#pragma unroll
                for (int mm = 0; mm < 2; ++mm)
#pragma unroll
                    for (int bj = 0; bj < 2; ++bj) { const float* rp = rbase + (size_t)(ai * HALF + (2 * mh + mm) * 16) * ldc + bj * HALF; rq[mm][bj][0] = *(const f32x4*)rp; rq[mm][bj][1] = *(const f32x4*)(rp + 4); }
                asm volatile("" : "+v"(rq[0][0][0]), "+v"(rq[0][0][1]), "+v"(rq[0][1][0]), "+v"(rq[0][1][1]), "+v"(rq[1][0][0]), "+v"(rq[1][0][1]), "+v"(rq[1][1][0]), "+v"(rq[1][1][1]));
#pragma unroll
                for (int mm = 0; mm < 2; ++mm) { const int m = 2 * mh + mm; const size_t ro = (size_t)(ai * HALF + m * 16) * ldc;
#pragma unroll
                    for (int bj = 0; bj < 2; ++bj) {
                        const f32x4 o0 = rq[mm][bj][0] * alpha + acc[ai][bj][m][0], o1 = rq[mm][bj][1] * alpha + acc[ai][bj][m][1];
                        u32x4 w; w.x = cvt_pk_bf16(o0[0], o0[1]); w.y = cvt_pk_bf16(o0[2], o0[3]); w.z = cvt_pk_bf16(o1[0], o1[1]); w.w = cvt_pk_bf16(o1[2], o1[3]);
                        *(u32x4*)(ob + ro + bj * HALF) = w; } }
            }
    }
};

template <class Epi, class Sched, bool ALIGN_EPI = false, bool SP2 = false>
__device__ __forceinline__ void gemm_phase(PG8_LAS unsigned char* lds, const Gemm g, const Sched& S, const Epi& E) {
    int tid_ = threadIdx.x; asm volatile("" : "+v"(tid_));
    const int tid = tid_, wid = __builtin_amdgcn_readfirstlane(tid >> 6), lane = tid & 63, wr = wid >> 2, wc = wid & 3, fr = lane & 15, fq = lane >> 4;
    const int K = g.K;
    unsigned voffA[2], voffB[2];
#pragma unroll
    for (int i = 0; i < 2; ++i) { int R, C; stage_rc(tid * 16 + i * 8192, R, C); const int Rb = Epi::PERM ? ((R & ~31) + perm32(R & 31)) : R;
        voffA[i] = (unsigned)(R * K + C) * 2u; voffB[i] = (unsigned)(Rb * K + C) * 2u; }
    const size_t kstep = (size_t)(BK * 2);
    const size_t hstep = (size_t)HALF * K * 2;
    const size_t tstep = 2 * hstep;
    const unsigned ldsw = (unsigned)wid * 1024u;
    const int aoff = lds_byte(wr * 64 + fr, fq * 8), boff = lds_byte(wc * 32 + fr, fq * 8);
#define PG8_SA(b, h) (((b) * 2 + (h)) * HTB)
#define PG8_SB(b, h) ((4 + (b) * 2 + (h)) * HTB)
#define PG8_STAGE(bufoff, gbase, voff) do { _Pragma("unroll") for (int _i = 0; _i < 2; ++_i) \
        __builtin_amdgcn_global_load_lds((const unsigned*)((const char*)(gbase) + (voff)[_i]), (PG8_LAS unsigned*)(lds + (bufoff) + ldsw + _i * 8192), 16, 0, 0); } while (0)
#define PG8_LDA(dst, b, h) do { _Pragma("unroll") for (int m = 0; m < 4; ++m) _Pragma("unroll") for (int k = 0; k < 2; ++k) dst[m][k] = *(const PG8_LAS bf16x8*)(lds + PG8_SA(b, h) + aoff + m * 2048 + k * 1024); } while (0)
#define PG8_LDB(dst, b, h) do { _Pragma("unroll") for (int n = 0; n < 2; ++n) _Pragma("unroll") for (int k = 0; k < 2; ++k) dst[n][k] = *(const PG8_LAS bf16x8*)(lds + PG8_SB(b, h) + boff + n * 2048 + k * 1024); } while (0)
#define PG8_MMA(ai, bj, At, Bt) do { __builtin_amdgcn_s_setprio(1); _Pragma("unroll") for (int m = 0; m < 4; ++m) _Pragma("unroll") for (int n = 0; n < 2; ++n) _Pragma("unroll") for (int k = 0; k < 2; ++k) \
        acc[ai][bj][m][n] = __builtin_amdgcn_mfma_f32_16x16x32_bf16(Bt[n][k], At[m][k], acc[ai][bj][m][n], 0, 0, 0); __builtin_amdgcn_s_setprio(0); } while (0)
#define PG8_WAIT_V(n) asm volatile("s_waitcnt vmcnt(" #n ")" ::: "memory")
#define PG8_WAIT_L(n) asm volatile("s_waitcnt lgkmcnt(" #n ")" ::: "memory")
#define PG8_BAR __builtin_amdgcn_s_barrier()
#define PG8_SCHED __builtin_amdgcn_sched_barrier(0)
    Unit cur, nxt; int ui = 0;
    if (!S.next(0, cur)) return;
    f32x4 acc[2][2][4][2];
#pragma unroll
    for (int a = 0; a < 2; ++a)
#pragma unroll
        for (int b = 0; b < 2; ++b)
#pragma unroll
            for (int m = 0; m < 4; ++m)
#pragma unroll
                for (int n = 0; n < 2; ++n) acc[a][b][m][n] = (f32x4){0.f, 0.f, 0.f, 0.f};
    bf16x8 At[4][2], B0[2][2], B1[2][2];
    const char* cA = (const char*)g.A + (size_t)cur.pm * tstep + (size_t)cur.k0 * kstep; const char* cB = (const char*)g.Bt + (size_t)cur.pn * tstep + (size_t)cur.k0 * kstep;
    S.a_ready(cur);
    if constexpr (SP2) {
        PG8_STAGE(PG8_SB(0, 0), cB, voffB); PG8_STAGE(PG8_SB(0, 1), cB + hstep, voffB); PG8_STAGE(PG8_SA(0, 0), cA, voffA); PG8_STAGE(PG8_SA(0, 1), cA + hstep, voffA);
        if (wr == 1) PG8_BAR;
        PG8_WAIT_V(2); PG8_BAR;
        PG8_STAGE(PG8_SB(1, 0), cB + kstep, voffB); PG8_STAGE(PG8_SA(1, 0), cA + kstep, voffA); PG8_STAGE(PG8_SB(1, 1), cB + hstep + kstep, voffB);
        PG8_WAIT_V(6); PG8_BAR;
    } else {
        PG8_STAGE(PG8_SB(0, 0), cB, voffB); PG8_STAGE(PG8_SA(0, 0), cA, voffA); PG8_STAGE(PG8_SB(0, 1), cB + hstep, voffB); PG8_STAGE(PG8_SA(0, 1), cA + hstep, voffA);
        if (wr == 1) PG8_BAR;
        PG8_WAIT_V(4); PG8_BAR;
        PG8_STAGE(PG8_SB(1, 0), cB + kstep, voffB); PG8_STAGE(PG8_SA(1, 0), cA + kstep, voffA); PG8_STAGE(PG8_SB(1, 1), cB + hstep + kstep, voffB);
        PG8_WAIT_V(6); PG8_BAR;
    }
    for (;;) {
        const bool has_next = S.next(ui + 1, nxt);
        const char* nA = has_next ? (const char*)g.A + (size_t)nxt.pm * tstep + (size_t)nxt.k0 * kstep : cA; const char* nB = has_next ? (const char*)g.Bt + (size_t)nxt.pn * tstep + (size_t)nxt.k0 * kstep : cB;
        const int nt = cur.nt;
        for (int t = 0; t < nt; t += 2) {
            const bool last = (t == nt - 2);
            const char* a1 = cA + (size_t)(t + 1) * kstep;
            const char* a2 = last ? nA : cA + (size_t)(t + 2) * kstep; const char* b2 = last ? nB : cB + (size_t)(t + 2) * kstep;
            const char* a3 = a2 + kstep; const char* b3 = b2 + kstep;
            if (last && has_next) S.a_ready(nxt);
            if constexpr (SP2) {
            PG8_LDB(B0, 0, 0); PG8_LDB(B1, 0, 1); PG8_SCHED; PG8_LDA(At, 0, 0); PG8_STAGE(PG8_SA(1, 1), a1 + hstep, voffA);
            PG8_WAIT_V(8); PG8_WAIT_L(0); PG8_BAR; PG8_MMA(0, 0, At, B0); PG8_MMA(0, 1, At, B1); PG8_BAR; PG8_SCHED;
            PG8_LDA(At, 0, 1); PG8_STAGE(PG8_SB(0, 0), b2, voffB); PG8_STAGE(PG8_SB(0, 1), b2 + hstep, voffB); PG8_STAGE(PG8_SA(0, 0), a2, voffA);
            PG8_WAIT_V(8); PG8_WAIT_L(0); PG8_BAR; PG8_MMA(1, 0, At, B0); PG8_MMA(1, 1, At, B1); PG8_BAR; PG8_SCHED;
            PG8_LDB(B0, 1, 0); PG8_LDB(B1, 1, 1); PG8_SCHED; PG8_LDA(At, 1, 0); PG8_STAGE(PG8_SA(0, 1), a2 + hstep, voffA);
            PG8_WAIT_V(8); PG8_WAIT_L(0); PG8_BAR; PG8_MMA(0, 0, At, B0); PG8_MMA(0, 1, At, B1); PG8_BAR; PG8_SCHED;
            PG8_LDA(At, 1, 1); PG8_STAGE(PG8_SB(1, 0), b3, voffB); PG8_STAGE(PG8_SB(1, 1), b3 + hstep, voffB); PG8_STAGE(PG8_SA(1, 0), a3, voffA);
            PG8_WAIT_V(8); PG8_WAIT_L(0); PG8_BAR; PG8_MMA(1, 0, At, B0); PG8_MMA(1, 1, At, B1); PG8_BAR; PG8_SCHED;
            } else {
            PG8_LDB(B0, 0, 0); PG8_SCHED; PG8_LDA(At, 0, 0); PG8_STAGE(PG8_SA(1, 1), a1 + hstep, voffA);
            PG8_WAIT_L(8); PG8_BAR; PG8_WAIT_L(0); PG8_MMA(0, 0, At, B0); PG8_BAR; PG8_SCHED;
            PG8_LDB(B1, 0, 1); PG8_STAGE(PG8_SB(0, 0), b2, voffB);
            PG8_BAR; PG8_WAIT_L(0); PG8_MMA(0, 1, At, B1); PG8_BAR;
            PG8_LDA(At, 0, 1); PG8_STAGE(PG8_SA(0, 0), a2, voffA);
            PG8_BAR; PG8_WAIT_L(0); PG8_MMA(1, 0, At, B0); PG8_BAR; PG8_SCHED;
            PG8_STAGE(PG8_SB(0, 1), b2 + hstep, voffB);
            PG8_WAIT_V(6); PG8_BAR; PG8_MMA(1, 1, At, B1); PG8_BAR;
            PG8_LDB(B0, 1, 0); PG8_SCHED; PG8_LDA(At, 1, 0); PG8_STAGE(PG8_SA(0, 1), a2 + hstep, voffA);
            PG8_WAIT_L(8); PG8_BAR; PG8_WAIT_L(0); PG8_MMA(0, 0, At, B0); PG8_BAR; PG8_SCHED;
            PG8_LDB(B1, 1, 1); PG8_STAGE(PG8_SB(1, 0), b3, voffB);
            PG8_BAR; PG8_WAIT_L(0); PG8_MMA(0, 1, At, B1); PG8_BAR;
            PG8_LDA(At, 1, 1); PG8_STAGE(PG8_SA(1, 0), a3, voffA);
            PG8_BAR; PG8_WAIT_L(0); PG8_MMA(1, 0, At, B0); PG8_BAR; PG8_SCHED;
            PG8_STAGE(PG8_SB(1, 1), b3 + hstep, voffB);
            PG8_WAIT_V(6); PG8_BAR; PG8_MMA(1, 1, At, B1); PG8_BAR;
            }
        }
        if constexpr (ALIGN_EPI) { if (wr == 0) PG8_BAR; }
        if constexpr (!Epi::AFTER_DRAIN) { E(acc, cur, wr, wc, fr, fq); S.done(cur); }
        if (!has_next) break;
#pragma unroll
        for (int a = 0; a < 2; ++a)
#pragma unroll
            for (int b = 0; b < 2; ++b)
#pragma unroll
                for (int m = 0; m < 4; ++m)
#pragma unroll
                    for (int n = 0; n < 2; ++n) acc[a][b][m][n] = (f32x4){0.f, 0.f, 0.f, 0.f};
        cur = nxt; cA = nA; cB = nB; ++ui;
        if constexpr (ALIGN_EPI) { if (wr == 1) PG8_BAR; }
    }
    PG8_WAIT_V(0);
    if constexpr (!ALIGN_EPI) { if (wr == 0) PG8_BAR; }
    PG8_BAR;
    if constexpr (Epi::AFTER_DRAIN) { E.fused(acc, cur, wr, wc, fr, fq, lds, wid, lane); S.done(cur); }
#undef PG8_SA
#undef PG8_SB
#undef PG8_STAGE
#undef PG8_LDA
#undef PG8_LDB
#undef PG8_MMA
#undef PG8_WAIT_V
#undef PG8_WAIT_L
#undef PG8_BAR
#undef PG8_SCHED
}
}
#define XB_TMO      128
#define XB_XCNT(j)  (256  + 64 * (j))
#define XB_XSUB(j)  (1280 + 64 * (j))
#define XB_XGEN(j)  (2304 + 64 * (j))
#define XB_TOP      3328
#define XB_TOPGEN   3392
#define XCD_BAR_WORDS 3456
#define XB_SPIN_CAP (1u << 18)
#define LAS __attribute__((address_space(3)))

__device__ __forceinline__ unsigned xb_ld(unsigned* p)              { return __hip_atomic_load(p, __ATOMIC_RELAXED, __HIP_MEMORY_SCOPE_AGENT); }
__device__ __forceinline__ unsigned xb_add(unsigned* p, unsigned v) { return __hip_atomic_fetch_add(p, v, __ATOMIC_RELAXED, __HIP_MEMORY_SCOPE_AGENT); }
__device__ __forceinline__ unsigned xb_xcc_id() { return (unsigned)__builtin_amdgcn_s_getreg((3 << 11) | 20) & 0xFu; }
#define XB_SPIN(cond, bar) do { unsigned _sp = 0; while (cond) { __builtin_amdgcn_s_sleep(1); \
    if ((++_sp & 255u) == 0u) { if (xb_ld(&(bar)[XB_TMO])) break; if (_sp > XB_SPIN_CAP) { atomicAdd(&(bar)[XB_TMO], 1u); break; } } } } while (0)

struct XcdBarrier {
    unsigned* bar; unsigned x;
    volatile LAS unsigned* st;
};

__device__ __forceinline__ XcdBarrier xcd_barrier_post(unsigned* bar, volatile LAS unsigned* st) {
    XcdBarrier b; b.bar = bar; b.x = xb_xcc_id(); b.st = st;
    if (threadIdx.x == 0) (void)xb_add(&bar[XB_XCNT(b.x)], 1u);
    return b;
}
__device__ __forceinline__ void xcd_barrier_complete(unsigned* bar, unsigned x, unsigned& nloc, unsigned& nx) {
    const unsigned G = gridDim.x * gridDim.y * gridDim.z;
    unsigned sum, cnt, mine, sp = 0u;
    for (;;) {
        sum = 0u; cnt = 0u; mine = 0u;
#pragma unroll
        for (unsigned j = 0; j < 16; ++j) { const unsigned c = xb_ld(&bar[XB_XCNT(j)]); sum += c; cnt += (c > 0u) ? 1u : 0u; mine = (j == x) ? c : mine; }
        if (sum == G) break;
        __builtin_amdgcn_s_sleep(1);
        if ((++sp & 255u) == 0u) { if (xb_ld(&bar[XB_TMO])) break; if (sp > XB_SPIN_CAP) { atomicAdd(&bar[XB_TMO], 1u); break; } }
    }
    nloc = mine > 0u ? mine : 1u; nx = cnt > 0u ? cnt : 1u;
}

__device__ __forceinline__ void xcd_barrier(const XcdBarrier& b) {
    asm volatile("s_waitcnt vmcnt(0)" ::: "memory");
    __syncthreads();
    if (threadIdx.x == 0) {
        unsigned* bar = b.bar;
        __builtin_amdgcn_s_waitcnt(0);
        unsigned nloc = b.st[0], nx = b.st[1];
        if (nloc == 0u) { xcd_barrier_complete(bar, b.x, nloc, nx); b.st[0] = nloc; b.st[1] = nx; }
        const unsigned old = xb_add(&bar[XB_XSUB(b.x)], 1u);
        const unsigned gen = old / nloc;
        if (old + 1u == (gen + 1u) * nloc) {
            __builtin_amdgcn_fence(__ATOMIC_RELEASE, "agent");
            asm volatile("s_waitcnt vmcnt(0)" ::: "memory");
            const unsigned og = xb_add(&bar[XB_TOP], 1u);
            const unsigned tg = og / nx;
            if (og + 1u == (tg + 1u) * nx) xb_add(&bar[XB_TOPGEN], 1u);
            else XB_SPIN(xb_ld(&bar[XB_TOPGEN]) == tg, bar);
            __builtin_amdgcn_fence(__ATOMIC_ACQUIRE, "agent");
            xb_add(&bar[XB_XGEN(b.x)], 1u);
            asm volatile("s_waitcnt vmcnt(0)" ::: "memory");
        } else {
            XB_SPIN(xb_ld(&bar[XB_XGEN(b.x)]) == gen, bar);
            __builtin_amdgcn_fence(__ATOMIC_ACQUIRE, "agent");
            asm volatile("s_waitcnt vmcnt(0)" ::: "memory");
        }
    }
    __syncthreads();
}

constexpr int D = 4096, NPROJ = 8192, CW = 2048, SW = 2048, NG = 128, NP = 64, DFF = 11008, NAV = 2 * DFF;
constexpr int TP = 16384, NSB = 8, TSQ = 64, M = TP + NSB * TSQ;
constexpr int NCHP = TP / 64, NCH = NCHP + NSB;
constexpr float LN_EPS = 1e-5f, ALPHA = 1.41421356237309515f;
constexpr int NPH = 11;
constexpr size_t O_Y = 0, O_CONV_P = 69206016, O_RE_P = 69214208, O_IM_P = 69230592, O_FFN_P = 69246976, O_CONV_S = 69291008, O_RE_S = 69356544, O_IM_S = 69487616, O_FFN_S = 69618688, OUT_TOTAL = 69970944;
constexpr size_t MiB = 1u << 20;
constexpr size_t WS_CTL = 0, CTL_ZERO_BYTES = 1 * MiB;
constexpr size_t WS_LB = 1 * MiB, WS_LB64 = WS_LB + 65536, WS_BBH = WS_LB64 + 65536, WS_CF = WS_BBH + 524288;
constexpr size_t WS_E = 3 * MiB, WS_HS = 19 * MiB;
constexpr size_t WS_WIN = 36 * MiB, WS_WGLU = 100 * MiB, WS_WOUT = 108 * MiB, WS_WAV = 140 * MiB, WS_WDN = 312 * MiB;
constexpr size_t WS_XB = 398 * MiB, WS_BIG = 794 * MiB, WS_END = 1504 * MiB;
constexpr size_t WS2_WIN = 530 * MiB, WS2_WGLU = 594 * MiB, WS2_WOUT = 602 * MiB, WS2_WDN = 634 * MiB, WS2_WAV = 1504 * MiB, WS_END2 = 1676 * MiB;
__device__ __forceinline__ size_t w_off(int which, bool second) {
    return which == 0 ? (second ? WS2_WIN : WS_WIN) : which == 1 ? (second ? WS2_WGLU : WS_WGLU) : which == 2 ? (second ? WS2_WOUT : WS_WOUT) : which == 3 ? (second ? WS2_WAV : WS_WAV) : (second ? WS2_WDN : WS_WDN); }
constexpr int CV_IN = 16384, CV_G1 = 34816, CV_G2 = 46336, CV_AV = 70656, CV_ALL = 92672, CV_NEXT = 8512;
constexpr size_t BIG_U = 0, BIG_SIDE2 = 66 * MiB, BIG_G = 264 * MiB;
constexpr size_t BIG_MIX = 330 * MiB, BIG_R = 0, BIG_A = 0, BIG_V = 355 * MiB;
constexpr size_t BIG_SLAB1 = 462 * MiB, BIG_SLAB2 = 264 * MiB, BIG_SIDE = 0;
static_assert((size_t)M * DFF * 2 <= 355 * MiB && BIG_V + (size_t)M * DFF * 2 <= WS_END - WS_BIG, "ws map");
constexpr int CW_BAR = 4096;
constexpr int RING_BYTES = 131072, LDSCTL_OFF = RING_BYTES, LDS_BYTES = 147456;

#define LAS __attribute__((address_space(3)))
typedef unsigned short bf16;
typedef unsigned u32x4 __attribute__((ext_vector_type(4)));
typedef unsigned u32x2 __attribute__((ext_vector_type(2)));
typedef float f32x4 __attribute__((ext_vector_type(4)));
typedef float f32x2 __attribute__((ext_vector_type(2)));
typedef float f32x16 __attribute__((ext_vector_type(16)));
typedef short bf16x8 __attribute__((ext_vector_type(8)));
#define LDS_WAIT() asm volatile("s_waitcnt lgkmcnt(0)" ::: "memory")
using pg8::cvt_pk_bf16; using pg8::bflo; using pg8::bfhi; using pg8::sigmoidf_;

__device__ __forceinline__ unsigned long long ldc8(const void* p) { return __hip_atomic_load((const unsigned long long*)p, __ATOMIC_RELAXED, __HIP_MEMORY_SCOPE_AGENT); }
__device__ __forceinline__ f32x2 ldc_f2(const void* p) { const unsigned long long w = ldc8(p); return (f32x2){__uint_as_float((unsigned)w), __uint_as_float((unsigned)(w >> 32))}; }
__device__ __forceinline__ bf16x8 ldc_frag(const void* p) { const unsigned long long a = ldc8(p), b = ldc8((const char*)p + 8); u32x4 w = {(unsigned)a, (unsigned)(a >> 32), (unsigned)b, (unsigned)(b >> 32)}; return __builtin_bit_cast(bf16x8, w); }
struct Args { const float* in[26]; float* out; unsigned char* ws; int ph_lo, ph_hi, w2, pad; };

__device__ __forceinline__ void transpose_item(const float* __restrict__ W, int K, int N, bf16* __restrict__ WT, int row_off, LAS float* scr, int item, int lane, int ilv = 0) {
    const int nblk = N / 32, kb = item / nblk, nb = item - kb * nblk, k0 = 64 * kb, n0 = 32 * nb;
    const int orow = (ilv == 1 || ilv == 2) ? (((n0 >> 7) << 8) + (n0 & 127) + (ilv == 2 ? 128 : 0)) : row_off + n0;
    const float* src = W + (size_t)(k0 + (lane >> 5)) * N + n0 + (lane & 31);
    float v[32];
#pragma unroll
    for (int i = 0; i < 32; ++i) v[i] = src[(size_t)(2 * i) * N];
#pragma unroll
    for (int i = 0; i < 32; ++i) scr[(2 * i + (lane >> 5)) * 33 + (lane & 31)] = v[i];
    LDS_WAIT();
    const int c = lane & 7;
#pragma unroll
    for (int j = 0; j < 4; ++j) { const int n = (lane >> 3) + 8 * j; const LAS float* s = scr + (8 * c) * 33 + n;
        u32x4 o; o.x = cvt_pk_bf16(s[0 * 33], s[1 * 33]); o.y = cvt_pk_bf16(s[2 * 33], s[3 * 33]); o.z = cvt_pk_bf16(s[4 * 33], s[5 * 33]); o.w = cvt_pk_bf16(s[6 * 33], s[7 * 33]);
        int orw = orow + n;
        if (ilv == 3) { const int sc = n0 + n, ty = sc >> 11, ch = sc & 2047, cl = ch & 63; orw = ((ch >> 6) << 8) + ((ty >> 1) << 7) + ((cl >> 4) << 5) + (((cl >> 2) & 3) << 3) + ((ty & 1) << 2) + (cl & 3); }
        *(u32x4*)(WT + (size_t)orw * K + k0 + 8 * c) = o; }
    LDS_WAIT();
}

__device__ __forceinline__ void convert_items(const Args& a, int layer, bool second, LAS unsigned char* L, int lo, int hi, int iw, int niw, int lane, int wave) {
    unsigned char* ws = a.ws; asm volatile("" : "+s"(ws));
    LAS float* scr = (LAS float*)(L + wave * 16384);
    constexpr int I_IN = (D / 64) * (NPROJ / 32), I_GLU = (SW / 64) * (SW / 32), I_OUT = (D / 64) * (D / 32), I_A = (D / 64) * (DFF / 32), I_DN = (DFF / 64) * (D / 32);
    constexpr int NITEMS = I_IN + I_GLU + I_OUT + 2 * I_A + I_DN;
    static_assert(CV_ALL == NITEMS && CV_IN == I_IN && CV_AV == I_IN + I_GLU + I_OUT + 2 * I_A, "conversion slices");
    if (hi > NITEMS) hi = NITEMS;
    const float* w_in = a.in[6] + (size_t)layer * D * NPROJ; const float* w_glu = a.in[16] + (size_t)layer * SW * SW; const float* w_out = a.in[17] + (size_t)layer * D * D;
    const float* w_a = a.in[20] + (size_t)layer * D * DFF; const float* w_v = a.in[21] + (size_t)layer * D * DFF; const float* w_dn = a.in[23] + (size_t)layer * DFF * D;
    for (int it = lo + iw; it < hi; it += niw) {
        int r = it;
        if (r < I_IN) { transpose_item(w_in, D, NPROJ, (bf16*)(ws + w_off(0, second)), 0, scr, r, lane, 3); continue; } r -= I_IN;
        if (r < I_GLU) { transpose_item(w_glu, SW, SW, (bf16*)(ws + w_off(1, second)), 0, scr, r, lane); continue; } r -= I_GLU;
        if (r < I_OUT) { transpose_item(w_out, D, D, (bf16*)(ws + w_off(2, second)), 0, scr, r, lane); continue; } r -= I_OUT;
        if (r < I_A) { transpose_item(w_a, D, DFF, (bf16*)(ws + w_off(3, second)), 0, scr, r, lane, 1); continue; } r -= I_A;
        if (r < I_A) { transpose_item(w_v, D, DFF, (bf16*)(ws + w_off(3, second)), 0, scr, r, lane, 2); continue; } r -= I_A;
        transpose_item(w_dn, DFF, D, (bf16*)(ws + w_off(4, second)), 0, scr, r, lane);
    }
}
__device__ __forceinline__ void all_convert(const Args& a, int layer, LAS unsigned char* L, int lo, int hi) {
    int t_ = threadIdx.x; asm volatile("" : "+v"(t_)); const int tid = t_, lane = tid & 63, wave = __builtin_amdgcn_readfirstlane(tid >> 6);
    convert_items(a, layer, false, L, lo, hi, (int)blockIdx.x * 8 + wave, (int)gridDim.x * 8, lane, wave);
}
__device__ __forceinline__ void tail_convert(const Args& a, int layer, LAS unsigned char* L, int rem, int lo, int hi) {
    int t_ = threadIdx.x; asm volatile("" : "+v"(t_)); const int tid = t_, lane = tid & 63, wave = __builtin_amdgcn_readfirstlane(tid >> 6);
    if ((int)blockIdx.x < rem) return;
    convert_items(a, layer, false, L, lo, hi, ((int)blockIdx.x - rem) * 8 + wave, ((int)gridDim.x - rem) * 8, lane, wave);
}

__device__ __forceinline__ void phase0(const Args& a, int layer, LAS unsigned char* L) {
    int t_ = threadIdx.x; asm volatile("" : "+v"(t_)); const int tid = t_, lane = tid & 63, wave = __builtin_amdgcn_readfirstlane(tid >> 6); (void)lane; (void)wave;
    unsigned char* ws = a.ws; asm volatile("" : "+s"(ws));
    const int gtid = blockIdx.x * 512 + tid, NT = gridDim.x * 512;
    if (gtid < NG * NP) {
        const int g = gtid >> 6, p = gtid & 63;
        const float dt = expf(a.in[10][layer * NG + g]);
        const float are = a.in[8][layer * NG * NP + gtid], aim = a.in[9][layer * NG * NP + gtid];
        const float mag = expf(are * dt), ang = aim * dt;
        const float lr = mag * cosf(ang), li = mag * sinf(ang);
        const float nr = lr - 1.0f, ni = li, den = are * are + aim * aim;
        const float cr = (nr * are + ni * aim) / den, ci = (ni * are - nr * aim) / den;
        float pr = lr, pi = li;
#pragma unroll
        for (int s = 0; s < 6; ++s) { const float tr = pr * pr - pi * pi, ti = 2.0f * pr * pi; pr = tr; pi = ti; }
        ((f32x2*)(ws + WS_LB))[gtid] = (f32x2){lr, li};
        ((f32x2*)(ws + WS_LB64))[gtid] = (f32x2){pr, pi};
        bf16* BBh = (bf16*)(ws + WS_BBH); bf16* CF = (bf16*)(ws + WS_CF);
        const float* bre = a.in[11] + ((size_t)layer * NG * NP + gtid) * 16; const float* bim = a.in[12] + ((size_t)layer * NG * NP + gtid) * 16;
#pragma unroll
        for (int c = 0; c < 16; c += 2) {
            const float br0 = bre[c], bi0 = bim[c], br1 = bre[c + 1], bi1 = bim[c + 1];
            const unsigned wre = cvt_pk_bf16(cr * br0 - ci * bi0, cr * br1 - ci * bi1), wim = cvt_pk_bf16(cr * bi0 + ci * br0, cr * bi1 + ci * br1);
            const int ln = (c >> 3) * 32 + (p & 31), j = c & 7;
            *(unsigned*)(BBh + ((size_t)(g * 4 + (p >> 5)) * 64 + ln) * 8 + j) = wre;
            *(unsigned*)(BBh + ((size_t)(g * 4 + 2 + (p >> 5)) * 64 + ln) * 8 + j) = wim;
        }
        const float* cre = a.in[13] + (size_t)layer * NG * 16 * NP + (size_t)g * 16 * NP + p; const float* cim = a.in[14] + (size_t)layer * NG * 16 * NP + (size_t)g * 16 * NP + p;
#pragma unroll
        for (int c = 0; c < 16; ++c) {
            const unsigned w = cvt_pk_bf16(cre[c * NP], -cim[c * NP]);
            const int kk = p >> 4, q = (p & 15) >> 2, ln = q * 16 + c, j0 = 2 * (p & 3);
            *(unsigned*)(CF + ((size_t)(g * 4 + kk) * 64 + ln) * 8 + j0) = w;
        }
    }
    if (layer == 0) {
        u32x4* xb = (u32x4*)(ws + WS_XB);
        const size_t n8 = (size_t)M * D / 8, np8 = (size_t)TP * D / 8;
        for (size_t i = gtid; i < n8; i += NT) {
            const f32x4* s = (i < np8) ? (const f32x4*)a.in[0] + 2 * i : (const f32x4*)a.in[1] + 2 * (i - np8);
            const f32x4 v0 = s[0], v1 = s[1];
            u32x4 o; o.x = cvt_pk_bf16(v0[0], v0[1]); o.y = cvt_pk_bf16(v0[2], v0[3]); o.z = cvt_pk_bf16(v1[0], v1[1]); o.w = cvt_pk_bf16(v1[2], v1[3]);
            xb[i] = o;
        }
    }
    convert_items(a, layer, false, L, (layer == 1 && gridDim.x == 256) ? CV_NEXT : 0, gridDim.x == 256 ? CV_IN : CV_ALL, blockIdx.x * 8 + wave, gridDim.x * 8, lane, wave);
}

#define S5_BU(afrag) \
    f32x16 xr_ = __builtin_amdgcn_mfma_f32_32x32x16_bf16(afrag, Bf[0], z16, 0, 0, 0), yr_ = __builtin_amdgcn_mfma_f32_32x32x16_bf16(afrag, Bf[1], z16, 0, 0, 0); \
    f32x16 xi_ = __builtin_amdgcn_mfma_f32_32x32x16_bf16(afrag, Bf[2], z16, 0, 0, 0), yi_ = __builtin_amdgcn_mfma_f32_32x32x16_bf16(afrag, Bf[3], z16, 0, 0, 0); \
    float bur[2][16], bui[2][16]; \
    _Pragma("unroll") for (int r = 0; r < 16; ++r) { \
        auto sr_ = __builtin_amdgcn_permlane32_swap(__float_as_uint(xr_[r]), __float_as_uint(yr_[r]), false, false); bur[0][r] = __uint_as_float(sr_[0]); bur[1][r] = __uint_as_float(sr_[1]); \
        auto si_ = __builtin_amdgcn_permlane32_swap(__float_as_uint(xi_[r]), __float_as_uint(yi_[r]), false, false); bui[0][r] = __uint_as_float(si_[0]); bui[1][r] = __uint_as_float(si_[1]); }

__device__ __forceinline__ void s5_pass_a(unsigned char* ws_) {
    size_t wz_ = 0; asm volatile("" : "+s"(wz_)); unsigned char* ws = ws_ + wz_;
    int t_ = threadIdx.x; asm volatile("" : "+v"(t_)); const int tid = t_, lane = tid & 63, wave = __builtin_amdgcn_readfirstlane(tid >> 6); (void)lane; (void)wave;
    const int gw = blockIdx.x * 8 + wave, g = gw & 127, s0 = gw >> 7, ns = (gridDim.x * 8) >> 7;
    if (ns == 0) return;
    const int cps = (NCHP + ns - 1) / ns, kb = s0 * cps, ke = (kb + cps < NCHP) ? kb + cps : NCHP;
    if (s0 >= ns - 1 || kb >= ke) return;
    const bf16* U = (const bf16*)(ws + WS_BIG + BIG_U);
    bf16x8 Bf[4];
#pragma unroll
    for (int j = 0; j < 4; ++j) Bf[j] = ldc_frag((const bf16*)(ws + WS_BBH) + ((size_t)(g * 4 + j) * 64 + lane) * 8);
    const f32x2 lb = ldc_f2((const f32x2*)(ws + WS_LB) + g * 64 + lane);
    const float lr = lb.x, li = lb.y;
    f32x16 z16;
#pragma unroll
    for (int i = 0; i < 16; ++i) z16[i] = 0.f;
    const size_t loff = (size_t)(lane & 31) * SW + 16 * g + 8 * (lane >> 5);
    bf16x8 a0, a1;
    { const bf16* up = U + (size_t)kb * 64 * SW + loff; a0 = *(const bf16x8*)up; a1 = *(const bf16x8*)(up + (size_t)32 * SW); }
    float hr = 0.f, hi = 0.f;
    for (int k = kb; k < ke; ++k) {
        bf16x8 n0 = a0, n1 = a1;
        if (k + 1 < ke) { const bf16* up = U + (size_t)(k + 1) * 64 * SW + loff; n0 = *(const bf16x8*)up; n1 = *(const bf16x8*)(up + (size_t)32 * SW); }
#pragma unroll
        for (int rt = 0; rt < 2; ++rt) {
            const bf16x8 af = rt ? a1 : a0;
            S5_BU(af)
#pragma unroll
            for (int aa = 0; aa < 4; ++aa)
#pragma unroll
                for (int h = 0; h < 2; ++h)
#pragma unroll
                    for (int i = 0; i < 4; ++i) { const int r = 4 * aa + i; const float tr = lr * hr - li * hi + bur[h][r], ti = lr * hi + li * hr + bui[h][r]; hr = tr; hi = ti; }
        }
        a0 = n0; a1 = n1;
    }
    ((f32x2*)(ws + WS_E))[(size_t)s0 * (NG * NP) + g * 64 + lane] = (f32x2){hr, hi};
}
__device__ __forceinline__ int s5_row0(int i, int nr, int kb, int s0, int ns) { return (i < nr) ? (kb + i) * 64 : TP + (s0 + (i - nr) * ns) * 64; }
__device__ __forceinline__ void s5_pass_c(const Args& a, int layer, LAS unsigned char* L) {
    int t_ = threadIdx.x; asm volatile("" : "+v"(t_)); const int tid = t_, lane = tid & 63, wave = __builtin_amdgcn_readfirstlane(tid >> 6); (void)lane; (void)wave;
    size_t wz_ = 0; asm volatile("" : "+s"(wz_)); unsigned char* ws = a.ws + wz_;
    const int gw = blockIdx.x * 8 + wave, g = gw & 127, s0 = gw >> 7, ns = (gridDim.x * 8) >> 7;
    if (ns == 0) return;
    const int cps = (NCHP + ns - 1) / ns, kb = s0 * cps, ke = (kb + cps < NCHP) ? kb + cps : NCHP;
    const int nr = ke > kb ? ke - kb : 0, nsm = (s0 < NSB) ? (NSB - 1 - s0) / ns + 1 : 0, cnt = nr + nsm;
    if (cnt == 0) return;
    const bf16* U = (const bf16*)(ws + WS_BIG + BIG_U); bf16* Gb = (bf16*)(ws + WS_BIG + BIG_G);
    bf16x8 Bf[4], Cf[4];
#pragma unroll
    for (int j = 0; j < 4; ++j) { Bf[j] = ldc_frag((const bf16*)(ws + WS_BBH) + ((size_t)(g * 4 + j) * 64 + lane) * 8); Cf[j] = ldc_frag((const bf16*)(ws + WS_CF) + ((size_t)(g * 4 + j) * 64 + lane) * 8); }
    const f32x2 lb = ldc_f2((const f32x2*)(ws + WS_LB) + g * 64 + lane);
    const float lr = lb.x, li = lb.y;
    const f32x4 dsk = *(const f32x4*)(a.in[15] + (size_t)layer * SW + 16 * g + 4 * (lane >> 4));
    f32x16 z16;
#pragma unroll
    for (int i = 0; i < 16; ++i) z16[i] = 0.f;
    LAS unsigned char* Hs = L + wave * 8704;
    const size_t loff = (size_t)(lane & 31) * SW + 16 * g + 8 * (lane >> 5);
    float hr = 0.f, hi = 0.f;
    if (nr > 0 && s0 > 0) {
        float pr = 1.f, pi = 0.f, br = lr, bi = li;
        for (int e = 64 * cps; e; e >>= 1) { if (e & 1) { const float tr = pr * br - pi * bi, ti = pr * bi + pi * br; pr = tr; pi = ti; } const float tr = br * br - bi * bi, ti = 2.f * br * bi; br = tr; bi = ti; }
        const f32x2* ep = (const f32x2*)(ws + WS_E) + g * 64 + lane;
        f32x2 ev[15];
#pragma unroll
        for (int sp = 0; sp < 15; ++sp) ev[sp] = (sp < s0) ? ldc_f2(ep + (size_t)sp * (NG * NP)) : (f32x2){0.f, 0.f};
#pragma unroll
        for (int sp = 0; sp < 15; ++sp) if (sp < s0) { const float tr = pr * hr - pi * hi + ev[sp].x, ti = pr * hi + pi * hr + ev[sp].y; hr = tr; hi = ti; }
        for (int sp = 15; sp < s0; ++sp) { const f32x2 e = ldc_f2(ep + (size_t)sp * (NG * NP)); const float tr = pr * hr - pi * hi + e.x, ti = pr * hi + pi * hr + e.y; hr = tr; hi = ti; }
    }
    bf16x8 a0, a1;
    u32x2 uwp[2][2];
    const size_t uoff = (size_t)(lane & 15) * SW + 16 * g + 4 * (lane >> 4);
    { const int r0 = s5_row0(0, nr, kb, s0, ns); const bf16* up = U + (size_t)r0 * SW + loff; a0 = *(const bf16x8*)up; a1 = *(const bf16x8*)(up + (size_t)32 * SW);
#pragma unroll
      for (int q = 0; q < 4; ++q) uwp[q >> 1][q & 1] = *(const u32x2*)(U + (size_t)(r0 + 16 * q) * SW + uoff); }
    for (int it = 0; it < cnt; ++it) {
        const int row0 = s5_row0(it, nr, kb, s0, ns);
        bf16x8 n0 = a0, n1 = a1;
        u32x2 uwn[2][2];
#pragma unroll
        for (int q = 0; q < 4; ++q) uwn[q >> 1][q & 1] = uwp[q >> 1][q & 1];
        if (it + 1 < cnt) { const int r1 = s5_row0(it + 1, nr, kb, s0, ns); const bf16* up = U + (size_t)r1 * SW + loff; n0 = *(const bf16x8*)up; n1 = *(const bf16x8*)(up + (size_t)32 * SW);
#pragma unroll
            for (int q = 0; q < 4; ++q) uwn[q >> 1][q & 1] = *(const u32x2*)(U + (size_t)(r1 + 16 * q) * SW + uoff); }
        float* ore; float* oim; bool last;
        if (it < nr) { last = (kb + it == NCHP - 1);
            ore = a.out + O_RE_P + (size_t)layer * NG * NP + g * 64 + lane; oim = a.out + O_IM_P + (size_t)layer * NG * NP + g * 64 + lane; }
        else { const int b = s0 + (it - nr) * ns; const size_t so = ((size_t)(layer * NSB + b) * NG + g) * NP + lane; hr = a.in[3][so]; hi = a.in[4][so]; asm volatile("" : "+v"(hr), "+v"(hi)); last = true;
            ore = a.out + O_RE_S + so; oim = a.out + O_IM_S + so; }
#pragma unroll
        for (int rt = 0; rt < 2; ++rt) {
            const bf16x8 af = rt ? a1 : a0;
            S5_BU(af)
#pragma unroll
            for (int aa = 0; aa < 4; ++aa)
#pragma unroll
                for (int h = 0; h < 2; ++h)
#pragma unroll
                    for (int i = 0; i < 4; ++i) { const int r = 4 * aa + i; const float tr = lr * hr - li * hi + bur[h][r], ti = lr * hi + li * hr + bui[h][r]; hr = tr; hi = ti;
                        *(LAS unsigned*)(Hs + (8 * aa + 4 * h + i) * 272 + 4 * lane) = cvt_pk_bf16(hr, hi); }
            LDS_WAIT();
#pragma unroll
            for (int m2 = 0; m2 < 2; ++m2) {
                f32x4 acc = {0.f, 0.f, 0.f, 0.f};
#pragma unroll
                for (int kk = 0; kk < 4; ++kk) { const bf16x8 hf = *(const LAS bf16x8*)(Hs + (16 * m2 + (lane & 15)) * 272 + 64 * kk + 16 * (lane >> 4)); acc = __builtin_amdgcn_mfma_f32_16x16x32_bf16(Cf[kk], hf, acc, 0, 0, 0); }
                const size_t row = (size_t)row0 + 32 * rt + 16 * m2 + (lane & 15);
                const u32x2 uw = uwp[rt][m2];
                const float y0 = acc[0] + dsk[0] * bflo(uw.x), y1 = acc[1] + dsk[1] * bfhi(uw.x), y2 = acc[2] + dsk[2] * bflo(uw.y), y3 = acc[3] + dsk[3] * bfhi(uw.y);
                const float g0 = y0 * sigmoidf_(1.5957691216f * (y0 + 0.044715f * y0 * y0 * y0)), g1 = y1 * sigmoidf_(1.5957691216f * (y1 + 0.044715f * y1 * y1 * y1));
                const float g2 = y2 * sigmoidf_(1.5957691216f * (y2 + 0.044715f * y2 * y2 * y2)), g3 = y3 * sigmoidf_(1.5957691216f * (y3 + 0.044715f * y3 * y3 * y3));
                u32x2 ow; ow.x = cvt_pk_bf16(g0, g1); ow.y = cvt_pk_bf16(g2, g3);
                *(u32x2*)(Gb + row * SW + 16 * g + 4 * (lane >> 4)) = ow;
            }
            LDS_WAIT();
        }
        if (last) { *ore = hr; *oim = hi; }
        a0 = n0; a1 = n1;
#pragma unroll
        for (int q = 0; q < 4; ++q) uwp[q >> 1][q & 1] = uwn[q >> 1][q & 1];
    }
}
__device__ __forceinline__ void mix_fix(const Args& a, int layer) {
    int t_ = threadIdx.x; asm volatile("" : "+v"(t_)); const int tid = t_;
    size_t wz_ = 0; asm volatile("" : "+s"(wz_)); unsigned char* ws = a.ws + wz_;
    const int gtid = blockIdx.x * 512 + tid, NT = gridDim.x * 512;
    const float* side = (const float*)(ws + WS_BIG + BIG_SIDE2); bf16* mix = (bf16*)(ws + WS_BIG + BIG_MIX);
    constexpr int NCG = CW / 4, NBLK = M / 64;
    for (int it = gtid; it < NBLK * NCG; it += NT) {
        const int blk = it / NCG, c0 = (it - blk * NCG) * 4;
        const float* cw = a.in[7] + (size_t)layer * 3 * CW + c0;
        f32x4 w0 = *(const f32x4*)cw, w1 = *(const f32x4*)(cw + CW), w2 = *(const f32x4*)(cw + 2 * CW);
        const float* sb = side + (size_t)blk * 6 * CW + c0;
        f32x4 z0 = *(const f32x4*)(sb + 2 * CW), z1 = *(const f32x4*)(sb + 3 * CW), b0 = *(const f32x4*)(sb + 4 * CW), b1 = *(const f32x4*)(sb + 5 * CW);
        f32x4 p0 = {0.f, 0.f, 0.f, 0.f}, p1 = p0;
        if (blk >= NCHP) { const float* sc = a.in[2] + ((size_t)(layer * NSB + (blk - NCHP)) * 2) * CW + c0; p0 = *(const f32x4*)sc; p1 = *(const f32x4*)(sc + CW); }
        else if (blk != 0) { const float* sp = side + (size_t)(blk - 1) * 6 * CW + c0; p0 = *(const f32x4*)sp; p1 = *(const f32x4*)(sp + CW); }
        asm volatile("" : "+v"(w0), "+v"(w1), "+v"(w2), "+v"(z0), "+v"(z1), "+v"(b0), "+v"(b1), "+v"(p0), "+v"(p1));
        const f32x4 y0 = b0 * (w0 * p0 + w1 * p1 + w2 * z0), y1 = b1 * (w0 * p1 + w1 * z0 + w2 * z1);
        u32x2 o0, o1; o0.x = cvt_pk_bf16(y0[0], y0[1]); o0.y = cvt_pk_bf16(y0[2], y0[3]); o1.x = cvt_pk_bf16(y1[0], y1[1]); o1.y = cvt_pk_bf16(y1[2], y1[3]);
        *(u32x2*)(mix + (size_t)(blk * 64) * D + c0) = o0; *(u32x2*)(mix + (size_t)(blk * 64 + 1) * D + c0) = o1;
        if (blk >= NCHP - 1) {
            float* o = (blk == NCHP - 1) ? a.out + O_CONV_P + (size_t)layer * 2 * CW + c0 : a.out + O_CONV_S + ((size_t)(layer * NSB + (blk - NCHP)) * 2) * CW + c0;
            *(f32x4*)o = *(const f32x4*)sb; *(f32x4*)(o + CW) = *(const f32x4*)(sb + CW);
        }
    }
}
__device__ __forceinline__ void ffn_fix(const Args& a, int layer) {
    int t_ = threadIdx.x; asm volatile("" : "+v"(t_)); const int tid = t_;
    size_t wz_ = 0; asm volatile("" : "+s"(wz_)); unsigned char* ws = a.ws + wz_;
    const int gtid = blockIdx.x * 512 + tid, NT = gridDim.x * 512;
    const bf16* side = (const bf16*)(ws + WS_BIG + BIG_SIDE); bf16* HG = (bf16*)(ws + WS_BIG + BIG_V);
    constexpr int NCG = DFF / 8, NBLK = M / 64;
    for (int it = gtid; it < NBLK * NCG; it += NT) {
        const int blk = it / NCG, cg = it - blk * NCG, c0 = cg * 8;
        float p0[8], p1[8], a0[8], a1[8], v0[8], v1[8], w0[8], w1[8], w2[8];
        const float* cw = a.in[22] + (size_t)layer * 3 * DFF + c0;
        f32x4 x0 = *(const f32x4*)cw, x1 = *(const f32x4*)(cw + 4), y0 = *(const f32x4*)(cw + DFF), y1 = *(const f32x4*)(cw + DFF + 4), z0 = *(const f32x4*)(cw + 2 * DFF), z1 = *(const f32x4*)(cw + 2 * DFF + 4);
        const bf16* sb = side + (size_t)blk * 6 * DFF + c0;
        u32x4 qa0 = *(const u32x4*)(sb + 2 * DFF), qa1 = *(const u32x4*)(sb + 3 * DFF), qv0 = *(const u32x4*)(sb + 4 * DFF), qv1 = *(const u32x4*)(sb + 5 * DFF);
        u32x4 q0 = {0u, 0u, 0u, 0u}, q1 = {0u, 0u, 0u, 0u};
        f32x4 s0 = {0.f, 0.f, 0.f, 0.f}, s1 = s0, s2 = s0, s3 = s0;
        if (blk >= NCHP) { const float* sc = a.in[5] + ((size_t)(layer * NSB + (blk - NCHP)) * 2) * DFF + c0; s0 = *(const f32x4*)sc; s1 = *(const f32x4*)(sc + 4); s2 = *(const f32x4*)(sc + DFF); s3 = *(const f32x4*)(sc + DFF + 4); }
        else if (blk != 0) { q0 = *(const u32x4*)(side + ((size_t)(blk - 1) * 6 + 0) * DFF + c0); q1 = *(const u32x4*)(side + ((size_t)(blk - 1) * 6 + 1) * DFF + c0); }
        asm volatile("" : "+v"(x0), "+v"(x1), "+v"(y0), "+v"(y1), "+v"(z0), "+v"(z1), "+v"(qa0), "+v"(qa1), "+v"(qv0), "+v"(qv1), "+v"(q0), "+v"(q1), "+v"(s0), "+v"(s1), "+v"(s2), "+v"(s3));
#pragma unroll
        for (int j = 0; j < 4; ++j) { w0[j] = x0[j]; w0[4 + j] = x1[j]; w1[j] = y0[j]; w1[4 + j] = y1[j]; w2[j] = z0[j]; w2[4 + j] = z1[j]; }
        if (blk >= NCHP) {
#pragma unroll
            for (int j = 0; j < 4; ++j) { p0[j] = s0[j]; p0[4 + j] = s1[j]; p1[j] = s2[j]; p1[4 + j] = s3[j]; }
        } else {
#pragma unroll
            for (int j = 0; j < 4; ++j) { p0[2 * j] = bflo(q0[j]); p0[2 * j + 1] = bfhi(q0[j]); p1[2 * j] = bflo(q1[j]); p1[2 * j + 1] = bfhi(q1[j]); }
        }
#pragma unroll
        for (int j = 0; j < 4; ++j) { a0[2 * j] = bflo(qa0[j]); a0[2 * j + 1] = bfhi(qa0[j]); a1[2 * j] = bflo(qa1[j]); a1[2 * j + 1] = bfhi(qa1[j]);
            v0[2 * j] = bflo(qv0[j]); v0[2 * j + 1] = bfhi(qv0[j]); v1[2 * j] = bflo(qv1[j]); v1[2 * j + 1] = bfhi(qv1[j]); }
        float h0[8], h1[8];
#pragma unroll
        for (int j = 0; j < 8; ++j) { const float c0v = w0[j] * p0[j] + w1[j] * p1[j] + w2[j] * a0[j], c1v = w0[j] * p1[j] + w1[j] * a0[j] + w2[j] * a1[j];
            h0[j] = c0v * sigmoidf_(c0v) * v0[j]; h1[j] = c1v * sigmoidf_(c1v) * v1[j]; }
        u32x4 o0, o1; o0.x = cvt_pk_bf16(h0[0], h0[1]); o0.y = cvt_pk_bf16(h0[2], h0[3]); o0.z = cvt_pk_bf16(h0[4], h0[5]); o0.w = cvt_pk_bf16(h0[6], h0[7]);
        o1.x = cvt_pk_bf16(h1[0], h1[1]); o1.y = cvt_pk_bf16(h1[2], h1[3]); o1.z = cvt_pk_bf16(h1[4], h1[5]); o1.w = cvt_pk_bf16(h1[6], h1[7]);
        *(u32x4*)(HG + (size_t)(blk * 64) * DFF + c0) = o0; *(u32x4*)(HG + (size_t)(blk * 64 + 1) * DFF + c0) = o1;
        if (blk >= NCHP - 1) {
            const u32x4 q0 = *(const u32x4*)(side + ((size_t)blk * 6 + 0) * DFF + c0), q1 = *(const u32x4*)(side + ((size_t)blk * 6 + 1) * DFF + c0);
            float* o = (blk == NCHP - 1) ? a.out + O_FFN_P + (size_t)layer * 2 * DFF + c0 : a.out + O_FFN_S + ((size_t)(layer * NSB + (blk - NCHP)) * 2) * DFF + c0;
            *(f32x4*)o = (f32x4){bflo(q0[0]), bfhi(q0[0]), bflo(q0[1]), bfhi(q0[1])}; *(f32x4*)(o + 4) = (f32x4){bflo(q0[2]), bfhi(q0[2]), bflo(q0[3]), bfhi(q0[3])};
            *(f32x4*)(o + DFF) = (f32x4){bflo(q1[0]), bfhi(q1[0]), bflo(q1[1]), bfhi(q1[1])}; *(f32x4*)(o + DFF + 4) = (f32x4){bflo(q1[2]), bfhi(q1[2]), bflo(q1[3]), bfhi(q1[3])};
        }
    }
}
__device__ __forceinline__ float wave_sum(float v) {
#pragma unroll
    for (int o = 1; o < 64; o <<= 1) v += __shfl_xor(v, o);
    return v;
}
__device__ __forceinline__ void ln_rows(const bf16* __restrict__ R, const float* __restrict__ gam, const float* __restrict__ bet, float* OF, bf16* OB, const float* slabs, const float* resB, const bf16* resBh, LAS unsigned char* L) {
    int t_ = threadIdx.x; asm volatile("" : "+v"(t_)); const int tid = t_, lane = tid & 63, wave = __builtin_amdgcn_readfirstlane(tid >> 6); (void)lane; (void)wave;
    const int gw = blockIdx.x * 8 + wave, NGW = gridDim.x * 8;
    for (int q = tid; q < D / 4; q += 512) { const int j = q >> 7, ln = (q & 127) >> 1, h = q & 1; LAS unsigned char* gl = L + j * 16384 + 8704 + (h * 64 + ln) * 16;
        *(LAS f32x4*)gl = ((const f32x4*)gam)[q]; *(LAS f32x4*)(gl + 2048) = ((const f32x4*)bet)[q]; }
    __syncthreads();
    const bool bal = (slabs != nullptr) && (NGW > 2 * (M - TP));
    const int m_first = bal ? (gw < M - TP ? TP + gw : gw - (M - TP)) : gw, m_step = bal ? (gw < M - TP ? M : NGW - (M - TP)) : NGW, m_end = bal ? (gw < M - TP ? M : TP) : M;
    u32x4 cx[8];
#pragma unroll
    for (int j = 0; j < 8; ++j) cx[j] = (u32x4){0u, 0u, 0u, 0u};
    if (m_first < m_end && !(slabs != nullptr && m_first >= TP)) { const u32x4* xr = (const u32x4*)(R + (size_t)m_first * D) + lane;
#pragma unroll
        for (int j = 0; j < 8; ++j) cx[j] = xr[64 * j]; }
    for (int m = m_first; m < m_end; m += m_step) {
        const int mn = m + m_step; const bool pre = (mn < m_end) && !(slabs != nullptr && mn >= TP);
        u32x4 nx[8];
#pragma unroll
        for (int j = 0; j < 8; ++j) nx[j] = cx[j];
        if (pre) { const u32x4* xr = (const u32x4*)(R + (size_t)mn * D) + lane;
#pragma unroll
            for (int j = 0; j < 8; ++j) nx[j] = xr[64 * j]; }
        f32x4 v[8][2]; float s = 0.f;
        if (slabs != nullptr && m >= TP) {
#define LN_PIN16(t) asm volatile("" : "+v"(t[0][0]), "+v"(t[0][1]), "+v"(t[1][0]), "+v"(t[1][1]), "+v"(t[2][0]), "+v"(t[2][1]), "+v"(t[3][0]), "+v"(t[3][1]), "+v"(t[4][0]), "+v"(t[4][1]), "+v"(t[5][0]), "+v"(t[5][1]), "+v"(t[6][0]), "+v"(t[6][1]), "+v"(t[7][0]), "+v"(t[7][1]))
            if (resBh != nullptr) { const u32x4* rh = (const u32x4*)(resBh + (size_t)(m - TP) * D) + lane;
                u32x4 hq[8];
#pragma unroll
                for (int j = 0; j < 8; ++j) hq[j] = rh[64 * j];
                asm volatile("" : "+v"(hq[0]), "+v"(hq[1]), "+v"(hq[2]), "+v"(hq[3]), "+v"(hq[4]), "+v"(hq[5]), "+v"(hq[6]), "+v"(hq[7]));
#pragma unroll
                for (int j = 0; j < 8; ++j) { const u32x4 hv = hq[j]; v[j][0] = (f32x4){bflo(hv.x), bfhi(hv.x), bflo(hv.y), bfhi(hv.y)} * ALPHA; v[j][1] = (f32x4){bflo(hv.z), bfhi(hv.z), bflo(hv.w), bfhi(hv.w)} * ALPHA; } }
            else { const f32x4* rr = (const f32x4*)(resB + (size_t)(m - TP) * D) + 2 * lane;
                f32x4 t[8][2];
#pragma unroll
                for (int j = 0; j < 8; ++j) { t[j][0] = rr[128 * j]; t[j][1] = rr[128 * j + 1]; }
                LN_PIN16(t);
#pragma unroll
                for (int j = 0; j < 8; ++j) { v[j][0] = t[j][0] * ALPHA; v[j][1] = t[j][1] * ALPHA; } }
            for (int sp = 0; sp < 8; ++sp) { const f32x4* sr = (const f32x4*)(slabs + ((size_t)sp * (M - TP) + (m - TP)) * D) + 2 * lane;
                f32x4 t[8][2];
#pragma unroll
                for (int j = 0; j < 8; ++j) { t[j][0] = sr[128 * j]; t[j][1] = sr[128 * j + 1]; }
                LN_PIN16(t);
#pragma unroll
                for (int j = 0; j < 8; ++j) { v[j][0] += t[j][0]; v[j][1] += t[j][1]; } }
#undef LN_PIN16
        } else {
#pragma unroll
            for (int j = 0; j < 8; ++j) { const u32x4 hv = cx[j]; v[j][0] = (f32x4){bflo(hv.x), bfhi(hv.x), bflo(hv.y), bfhi(hv.y)}; v[j][1] = (f32x4){bflo(hv.z), bfhi(hv.z), bflo(hv.w), bfhi(hv.w)}; }
        }
#pragma unroll
        for (int j = 0; j < 8; ++j)
#pragma unroll
            for (int h = 0; h < 2; ++h) s += (v[j][h][0] + v[j][h][1]) + (v[j][h][2] + v[j][h][3]);
        const float mean = wave_sum(s) * (1.f / D); float s2 = 0.f;
#pragma unroll
        for (int j = 0; j < 8; ++j)
#pragma unroll
            for (int h = 0; h < 2; ++h) { v[j][h] = v[j][h] - mean; s2 += (v[j][h][0] * v[j][h][0] + v[j][h][1] * v[j][h][1]) + (v[j][h][2] * v[j][h][2] + v[j][h][3] * v[j][h][3]); }
        const float rstd = 1.f / sqrtf(wave_sum(s2) * (1.f / D) + LN_EPS);
#pragma unroll
        for (int j = 0; j < 8; ++j) {
            const LAS f32x4* gl = (const LAS f32x4*)(L + j * 16384 + 8704) + lane;
            const f32x4 o0 = v[j][0] * rstd * gl[0] + gl[128], o1 = v[j][1] * rstd * gl[64] + gl[192];
            if (OF) { f32x4* op = (f32x4*)(OF + (size_t)m * D) + 128 * j + 2 * lane; op[0] = o0; op[1] = o1; }
            if (OB) { u32x4 w; w.x = cvt_pk_bf16(o0[0], o0[1]); w.y = cvt_pk_bf16(o0[2], o0[3]); w.z = cvt_pk_bf16(o1[0], o1[1]); w.w = cvt_pk_bf16(o1[2], o1[3]); ((u32x4*)(OB + (size_t)m * D))[lane + 64 * j] = w; }
        }
#pragma unroll
        for (int j = 0; j < 8; ++j) cx[j] = nx[j];
    }
}

__global__ void __launch_bounds__(512, 2) fwd(Args args) {
    extern __shared__ __attribute__((aligned(16))) unsigned char lds[];
    LAS unsigned char* L = (LAS unsigned char*)lds;
    const int tid = threadIdx.x;
    const int G = gridDim.x;
    unsigned char* ws = args.ws;
    for (int u = tid; u < (LDS_BYTES - LDSCTL_OFF) / 4; u += 512) ((LAS unsigned*)(L + LDSCTL_OFF))[u] = 0u;
    __syncthreads();
    const int lo = args.ph_lo, hi = args.ph_hi;
    const bool use_bar = (hi - lo) > 1;
    XcdBarrier bar; bar.bar = (unsigned*)(ws + WS_CTL) + CW_BAR; bar.x = 0; bar.st = (volatile LAS unsigned*)(L + LDSCTL_OFF);
    if (use_bar) bar = xcd_barrier_post((unsigned*)(ws + WS_CTL) + CW_BAR, (volatile LAS unsigned*)(L + LDSCTL_OFF));
#define IN(k) (lo <= (k) && (k) < hi)
#define SEAM(k) do { if (IN(k) && IN((k) + 1)) xcd_barrier(bar); } while (0)

    for (int layer = 0; layer < 2; ++layer) {
        const int pb = layer * NPH;
        const bool split_ok = (G == 256);
        const bool wsec = false, tails = (G == 256);
        if (layer == 0) { if (IN(pb + 0)) { phase0(args, 0, L); } SEAM(pb + 0); }
        if (IN(pb + 1)) {
            unsigned char* ws = args.ws; asm volatile("" : "+s"(ws));
            pg8::Gemm g{(const bf16*)(ws + WS_XB), (const bf16*)(ws + w_off(0, wsec)), M, NPROJ, D}; pg8::TwoPartOrder S; S.init(M, TP, NPROJ, G, (int)blockIdx.x, D);
            pg8::EpiMix E{(bf16*)(ws + WS_BIG + BIG_MIX), D, (bf16*)(ws + WS_BIG + BIG_U), SW, args.in[7] + (size_t)layer * 3 * CW, CW, (float*)(ws + WS_BIG + BIG_SIDE2)};
            pg8::gemm_phase<pg8::EpiMix, pg8::TwoPartOrder, true, true>(L, g, S, E);
            if (tails) tail_convert(args, layer, L, S.nwg % G, CV_IN, CV_G1);
        } SEAM(pb + 1);
        if (IN(pb + 2)) { s5_pass_a(ws); mix_fix(args, layer); } SEAM(pb + 2);
        if (IN(pb + 3)) { s5_pass_c(args, layer, L); } SEAM(pb + 3);
        if (IN(pb + 4)) {
            unsigned char* ws = args.ws; asm volatile("" : "+s"(ws));
            pg8::Gemm g{(const bf16*)(ws + WS_BIG + BIG_G), (const bf16*)(ws + w_off(1, wsec)), M, SW, SW}; pg8::TwoPartOrder S; S.init(M, TP, SW, G, (int)blockIdx.x, SW);
            pg8::EpiGlu E{(const bf16*)(ws + WS_BIG + BIG_G), SW, (bf16*)(ws + WS_BIG + BIG_MIX), D, CW};
            pg8::gemm_phase<pg8::EpiGlu, pg8::TwoPartOrder, true, true>(L, g, S, E);
            if (tails) tail_convert(args, layer, L, S.nwg % G, CV_G1, CV_G2);
        } SEAM(pb + 4);
        if (IN(pb + 5)) {
            unsigned char* ws = args.ws; asm volatile("" : "+s"(ws));
            pg8::Gemm g{(const bf16*)(ws + WS_BIG + BIG_MIX), (const bf16*)(ws + w_off(2, wsec)), M, D, D}; pg8::SplitOrder S; S.init(M, TP, D, G, (int)blockIdx.x, D);
            pg8::EpiRes E{args.in[0], args.in[1], layer == 0 ? (const bf16*)nullptr : (const bf16*)(ws + WS_XB), TP, (bf16*)(ws + WS_BIG + BIG_R), D, ALPHA, (float*)(ws + WS_BIG + BIG_SLAB1), (size_t)(M - TP) * D};
            pg8::gemm_phase<pg8::EpiRes, pg8::SplitOrder, true, true>(L, g, S, E);
        } SEAM(pb + 5);
        if (IN(pb + 6)) { ln_rows((const bf16*)(ws + WS_BIG + BIG_R), args.in[18] + (size_t)layer * D, args.in[19] + (size_t)layer * D, (float*)nullptr, (bf16*)(ws + WS_XB), split_ok ? (const float*)(ws + WS_BIG + BIG_SLAB1) : (const float*)nullptr, args.in[1], layer == 0 ? (const bf16*)nullptr : (const bf16*)(ws + WS_XB) + (size_t)TP * D, L); if (tails) all_convert(args, layer, L, CV_G2, CV_AV); } SEAM(pb + 6);
        if (IN(pb + 7)) {
            unsigned char* ws = args.ws; asm volatile("" : "+s"(ws));
            pg8::Gemm g{(const bf16*)(ws + WS_XB), (const bf16*)(ws + w_off(3, wsec)), M, NAV, D}; pg8::TwoPartOrder S; S.init(M, TP, NAV, G, (int)blockIdx.x, D);
            pg8::EpiGate E{(bf16*)(ws + WS_BIG + BIG_V), DFF, args.in[22] + (size_t)layer * 3 * DFF, (bf16*)(ws + WS_BIG + BIG_SIDE)};
            pg8::gemm_phase<pg8::EpiGate, pg8::TwoPartOrder, true, true>(L, g, S, E);
            if (tails) { tail_convert(args, layer, L, S.nwg % G, CV_AV, CV_ALL); if (layer == 0) tail_convert(args, 1, L, S.nwg % G, 0, CV_NEXT); }
        } SEAM(pb + 7);
        if (IN(pb + 8)) { ffn_fix(args, layer); } SEAM(pb + 8);
        if (IN(pb + 9)) {
            unsigned char* ws = args.ws; asm volatile("" : "+s"(ws));
            pg8::Gemm g{(const bf16*)(ws + WS_BIG + BIG_V), (const bf16*)(ws + w_off(4, wsec)), M, D, DFF}; pg8::SplitOrder S; S.init(M, TP, D, G, (int)blockIdx.x, DFF); S.full.wgm = 2; S.all.wgm = 2;
            pg8::EpiRes E{nullptr, nullptr, (const bf16*)(ws + WS_XB), TP, (bf16*)(ws + WS_BIG + BIG_R), D, ALPHA, (float*)(ws + WS_BIG + BIG_SLAB2), (size_t)(M - TP) * D};
            pg8::gemm_phase<pg8::EpiRes, pg8::SplitOrder, true, true>(L, g, S, E);
        } SEAM(pb + 9);
        if (IN(pb + 10)) {
            ln_rows((const bf16*)(ws + WS_BIG + BIG_R), args.in[24] + (size_t)layer * D, args.in[25] + (size_t)layer * D,
                    layer == 0 ? (float*)nullptr : args.out + O_Y, layer == 0 ? (bf16*)(ws + WS_XB) : (bf16*)nullptr, split_ok ? (const float*)(ws + WS_BIG + BIG_SLAB2) : (const float*)nullptr, (const float*)nullptr, (const bf16*)(ws + WS_XB) + (size_t)TP * D, L);
            if (layer == 0) phase0(args, 1, L);
        } SEAM(pb + 10);
    }
#undef IN
#undef SEAM
}

#ifndef MK_ONE_LAUNCH
#define MK_ONE_LAUNCH 1
#endif
extern "C" void kernel_launch(void* const* d_in, const int* in_sizes, int n_in, void* d_out, int out_size, void* d_ws, size_t ws_size, hipStream_t stream) {
    static int grid = 0;
    if (grid == 0) {
        if (n_in != 26 || in_sizes[0] != TP * D || (size_t)out_size != OUT_TOTAL || ws_size < WS_END) {   fprintf(stderr, "kernel_launch: unexpected shapes (n_in %d, in0 %d, out %d, ws %zu)\n", n_in, n_in > 0 ? in_sizes[0] : -1, out_size, ws_size); grid = -1; return; }
        int dev = 0, cus = 0, per_cu = 0;
        if (hipGetDevice(&dev) != hipSuccess || hipDeviceGetAttribute(&cus, hipDeviceAttributeMultiprocessorCount, dev) != hipSuccess) { grid = -1; return; }
        if (hipFuncSetAttribute((const void*)fwd, hipFuncAttributeMaxDynamicSharedMemorySize, LDS_BYTES) != hipSuccess) { fprintf(stderr, "kernel_launch: hipFuncSetAttribute failed\n"); grid = -1; return; }
        if (hipOccupancyMaxActiveBlocksPerMultiprocessor(&per_cu, (const void*)fwd, 512, LDS_BYTES) != hipSuccess || per_cu < 1) { fprintf(stderr, "kernel_launch: occupancy query says %d\n", per_cu); (void)hipGetLastError(); grid = -1; return; }
        grid = cus;
    }
    if (grid < 0) return;
    if (hipMemsetAsync((char*)d_ws + WS_CTL, 0, CTL_ZERO_BYTES, stream) != hipSuccess) return;
    Args a{};
    for (int i = 0; i < 26; ++i) a.in[i] = (const float*)d_in[i];
    a.out = (float*)d_out; a.ws = (unsigned char*)d_ws; a.w2 = 0; a.pad = 0;
#if MK_ONE_LAUNCH
    a.ph_lo = 0; a.ph_hi = 2 * NPH;
    hipLaunchKernelGGL(fwd, dim3(grid), dim3(512), LDS_BYTES, stream, a);
#else
#ifndef PROBE_MASK
#define PROBE_MASK 0
#endif
#ifndef PROBE_REPS
#define PROBE_REPS 1
#endif
    for (int ph = 0; ph < 2 * NPH; ++ph) { const int reps = ((PROBE_MASK >> (ph % NPH)) & 1) ? PROBE_REPS : 1;
        for (int r = 0; r < reps; ++r) { a.ph_lo = ph; a.ph_hi = ph + 1; hipLaunchKernelGGL(fwd, dim3(grid), dim3(512), LDS_BYTES, stream, a); } }
#endif
}
```

```cpp
#include <hip/hip_runtime.h>
#include <cstdio>
#include <cstdint>
namespace pg8 {
#define PG8_LAS __attribute__((address_space(3)))
typedef unsigned short bf16_t;
typedef short bf16x8 __attribute__((ext_vector_type(8)));
typedef float f32x4 __attribute__((ext_vector_type(4)));
typedef unsigned u32x4 __attribute__((ext_vector_type(4)));
typedef unsigned u32x2 __attribute__((ext_vector_type(2)));
constexpr int BM = 256, BK = 64, HALF = 128, HTB = HALF * BK * 2  , STAGE_BYTES = 8 * HTB, NXCD = 8, WGM = 8;

__host__ __device__ __forceinline__ int lds_byte(int r, int c) { const int st = (r >> 4) * 2 + (c >> 5), rr = r & 15, cc = c & 31, ob = rr * 64 + cc * 2; return st * 1024 + (ob ^ (((ob >> 9) & 1) << 5)); }
__host__ __device__ __forceinline__ void stage_rc(int b, int& R, int& C) { const int st = b / 1024, sb = b % 1024, swz = sb ^ (((sb >> 9) & 1) << 5); R = (st >> 1) * 16 + swz / 64; C = (st & 1) * 32 + (swz % 64) / 2; }
__host__ __device__ __forceinline__ int perm32(int rho) { const int n = rho >> 4, i = rho & 15; return 8 * (i >> 2) + 4 * n + (i & 3); }

struct Unit { int pm, pn, k0, nt, slab; };
struct Gemm { const bf16_t* A; const bf16_t* Bt; int M, N, K; };

struct StaticOrder {
    int nM, nN, nwg, G, c, ntk, wgm = WGM;
    __host__ __device__ void init(int M, int N, int G_, int c_, int K_) { nM = M / BM; nN = N / BM; nwg = nM * nN; G = G_; c = c_; ntk = K_ / BK; }
    __host__ __device__ bool next(int i, Unit& u) const { return at((long)i * G + c, u); }
    __host__ __device__ bool at(long L, Unit& u) const {
        if (L >= nwg) return false;
        int wgid = (int)L; { const int q = nwg / NXCD, r = nwg % NXCD, xcd = wgid % NXCD, off = wgid / NXCD; wgid = (xcd < r ? xcd * (q + 1) : r * (q + 1) + (xcd - r) * q) + off; }
        const int nig = wgm * nN, gid = wgid / nig, fm = gid * wgm, gsz = (nM - fm) < wgm ? (nM - fm) : wgm;
        u.pm = fm + ((wgid % nig) % gsz); u.pn = (wgid % nig) / gsz; u.k0 = 0; u.nt = ntk; u.slab = -1; return true;
    }
    __device__ __forceinline__ void a_ready(const Unit&) const {}
    __device__ __forceinline__ void done(const Unit&) const {}
};
struct TwoPartOrder {
    StaticOrder full, rest; int nwg, G, c; bool two;
    __host__ __device__ void init(int M, int Mfull, int N, int G_, int c_, int K_) { full.init(Mfull, N, G_, c_, K_); rest.init(M - Mfull, N, G_, c_, K_); G = G_; c = c_; nwg = full.nwg + rest.nwg;
        two = (full.nwg % NXCD == 0); if (!two) { full.init(M, N, G_, c_, K_); rest.nwg = 0; } }
    __host__ __device__ bool next(int i, Unit& u) const {
        const long L = (long)i * G + c;
        if (L < full.nwg) return full.at(L, u);
        if (!rest.at(L - full.nwg, u)) return false;
        u.pm += full.nM; return true;
    }
    __device__ __forceinline__ void a_ready(const Unit&) const {}
    __device__ __forceinline__ void done(const Unit&) const {}
};
struct SplitOrder {
    StaticOrder full, all; int nfr, nN, G, c, ntk; bool split;
    static constexpr int NSPLIT = 8;
    __host__ __device__ void init(int M, int Mfull, int N, int G_, int c_, int K_) { full.init(Mfull, N, G_, c_, K_); all.init(M, N, G_, c_, K_); nN = N / BM; G = G_; c = c_; ntk = K_ / BK;
        nfr = full.nwg / G_; split = (full.nwg % G_ == 0) && (((M - Mfull) / BM) * nN * NSPLIT == G_) && (ntk / 2 >= NSPLIT); }
    __host__ __device__ bool next(int i, Unit& u) const {
        if (!split) return all.next(i, u);
        if (i < nfr) return full.next(i, u);
        if (i > nfr) return false;
        const int e = c / NSPLIT, sp = c % NSPLIT, pairs = ntk / 2, base = pairs / NSPLIT, rem = pairs % NSPLIT;
        u.pm = full.nM + e / nN; u.pn = e % nN; u.k0 = 2 * (sp * base + (sp < rem ? sp : rem)); u.nt = 2 * (base + (sp < rem ? 1 : 0)); u.slab = sp; return true;
    }
    __device__ __forceinline__ void a_ready(const Unit&) const {}
    __device__ __forceinline__ void done(const Unit&) const {}
};

__device__ __forceinline__ unsigned cvt_pk_bf16(float lo, float hi) { unsigned r; asm volatile("v_cvt_pk_bf16_f32 %0, %1, %2" : "=v"(r) : "v"(lo), "v"(hi)); return r; }
typedef float f32x2 __attribute__((ext_vector_type(2)));
__device__ __forceinline__ float bflo(unsigned w) { return __uint_as_float(w << 16); }
__device__ __forceinline__ float bfhi(unsigned w) { return __uint_as_float(w & 0xffff0000u); }
__device__ __forceinline__ float sigmoidf_(float x) { return __builtin_amdgcn_rcpf(1.0f + __expf(-x)); }

struct EpiBf16 {
    static constexpr bool PERM = true, AFTER_DRAIN = false;
    bf16_t* O; int ldc; int split_cols; size_t split_stride;
    __device__ __forceinline__ void operator()(const f32x4 (&acc)[2][2][4][2], const Unit& u, int wr, int wc, int fr, int fq) const {
        const int row0 = u.pm * BM + wr * 64 + fr; int colt = u.pn * BM; bf16_t* base = O;
        if (split_cols) { const int t = colt / split_cols; base += (size_t)t * split_stride; colt -= t * split_cols; }
        const int col0 = colt + wc * 32 + 8 * fq;
#pragma unroll
        for (int ai = 0; ai < 2; ++ai)
#pragma unroll
            for (int m = 0; m < 4; ++m) { bf16_t* rowp = base + (size_t)(row0 + ai * HALF + m * 16) * ldc + col0;
#pragma unroll
                for (int bj = 0; bj < 2; ++bj) { const f32x4 v0 = acc[ai][bj][m][0], v1 = acc[ai][bj][m][1];
                    u32x4 w; w.x = cvt_pk_bf16(v0[0], v0[1]); w.y = cvt_pk_bf16(v0[2], v0[3]); w.z = cvt_pk_bf16(v1[0], v1[1]); w.w = cvt_pk_bf16(v1[2], v1[3]);
                    *(u32x4*)(rowp + bj * HALF) = w; } }
    }
};

__device__ __forceinline__ float dpp_ror1(float x) { return __int_as_float(__builtin_amdgcn_update_dpp(0, __float_as_int(x), 0x121, 0xF, 0xF, true)); }
__device__ __forceinline__ float dpp_ror2(float x) { return __int_as_float(__builtin_amdgcn_update_dpp(0, __float_as_int(x), 0x122, 0xF, 0xF, true)); }
struct EpiGate {
    static constexpr bool PERM = true, AFTER_DRAIN = false;
    bf16_t* HG; int ldh; const float* cw; bf16_t* side;
    __device__ __forceinline__ void operator()(const f32x4 (&acc)[2][2][4][2], const Unit& u, int wr, int wc, int fr, int fq) const {
        const int ch0 = u.pn * 128 + wc * 32 + 8 * fq;
        f32x4 w0[2], w1[2], w2[2];
#pragma unroll
        for (int n = 0; n < 2; ++n) { w0[n] = *(const f32x4*)(cw + ch0 + 4 * n); w1[n] = *(const f32x4*)(cw + ldh + ch0 + 4 * n); w2[n] = *(const f32x4*)(cw + 2 * ldh + ch0 + 4 * n); }
        const bool f1 = fr >= 1, f2 = fr >= 2;
#pragma unroll
        for (int ai = 0; ai < 2; ++ai) {
            const int blk = u.pm * 4 + ai * 2 + wr;
#pragma unroll
            for (int m = 0; m < 4; ++m) {
                const size_t row = (size_t)(u.pm * BM + ai * HALF + wr * 64 + m * 16 + fr);
                float hg[8];
#pragma unroll
                for (int n = 0; n < 2; ++n)
#pragma unroll
                    for (int i = 0; i < 4; ++i) {
                        const float cur = acc[ai][0][m][n][i], prv = (m > 0) ? acc[ai][0][m > 0 ? m - 1 : 0][n][i] : cur;
                        const float r1c = dpp_ror1(cur), r1p = dpp_ror1(prv), r2c = dpp_ror2(cur), r2p = dpp_ror2(prv);
                        const float tm1 = f1 ? r1c : r1p, tm2 = f2 ? r2c : r2p;
                        const float cv = w0[n][i] * tm2 + w1[n][i] * tm1 + w2[n][i] * cur;
                        hg[4 * n + i] = cv * sigmoidf_(cv) * acc[ai][1][m][n][i];
                    }
                if (m == 0 && fr < 2) {
                    const f32x4 a0 = acc[ai][0][0][0], a1 = acc[ai][0][0][1], v0 = acc[ai][1][0][0], v1 = acc[ai][1][0][1];
                    u32x4 wa, wv; wa.x = cvt_pk_bf16(a0[0], a0[1]); wa.y = cvt_pk_bf16(a0[2], a0[3]); wa.z = cvt_pk_bf16(a1[0], a1[1]); wa.w = cvt_pk_bf16(a1[2], a1[3]);
                    wv.x = cvt_pk_bf16(v0[0], v0[1]); wv.y = cvt_pk_bf16(v0[2], v0[3]); wv.z = cvt_pk_bf16(v1[0], v1[1]); wv.w = cvt_pk_bf16(v1[2], v1[3]);
                    *(u32x4*)(side + ((size_t)blk * 6 + 2 + fr) * ldh + ch0) = wa; *(u32x4*)(side + ((size_t)blk * 6 + 4 + fr) * ldh + ch0) = wv;
                } else {
                    u32x4 w; w.x = cvt_pk_bf16(hg[0], hg[1]); w.y = cvt_pk_bf16(hg[2], hg[3]); w.z = cvt_pk_bf16(hg[4], hg[5]); w.w = cvt_pk_bf16(hg[6], hg[7]);
                    *(u32x4*)(HG + row * ldh + ch0) = w;
                }
                if (m == 3 && fr >= 14) {
                    const f32x4 a0 = acc[ai][0][3][0], a1 = acc[ai][0][3][1];
                    u32x4 wa; wa.x = cvt_pk_bf16(a0[0], a0[1]); wa.y = cvt_pk_bf16(a0[2], a0[3]); wa.z = cvt_pk_bf16(a1[0], a1[1]); wa.w = cvt_pk_bf16(a1[2], a1[3]);
                    *(u32x4*)(side + ((size_t)blk * 6 + (fr - 14)) * ldh + ch0) = wa;
                }
            }
        }
    }
};


struct EpiMix {
    static constexpr bool PERM = true, AFTER_DRAIN = false;
    bf16_t* MX; int ldm; bf16_t* U; int ldu; const float* cw; int ldw; float* side;
    __device__ __forceinline__ void operator()(const f32x4 (&acc)[2][2][4][2], const Unit& u, int wr, int wc, int fr, int fq) const {
        const int ch0 = u.pn * 64 + wc * 16 + 4 * fq;
        const f32x4 w0 = *(const f32x4*)(cw + ch0), w1 = *(const f32x4*)(cw + ldw + ch0), w2 = *(const f32x4*)(cw + 2 * ldw + ch0);
        const bool f1 = fr >= 1, f2 = fr >= 2;
#pragma unroll
        for (int ai = 0; ai < 2; ++ai) {
            const int blk = u.pm * 4 + ai * 2 + wr;
            f32x4 zp = {0.f, 0.f, 0.f, 0.f};
#pragma unroll
            for (int m = 0; m < 4; ++m) {
                const size_t row = (size_t)(u.pm * BM + ai * HALF + wr * 64 + m * 16 + fr);
                const f32x4 z = acc[ai][0][m][1] * acc[ai][1][m][0];
                f32x4 ya;
#pragma unroll
                for (int i = 0; i < 4; ++i) {
                    const float r1c = dpp_ror1(z[i]), r1p = dpp_ror1(zp[i]), r2c = dpp_ror2(z[i]), r2p = dpp_ror2(zp[i]);
                    const float tm1 = f1 ? r1c : r1p, tm2 = f2 ? r2c : r2p;
                    ya[i] = acc[ai][0][m][0][i] * (w0[i] * tm2 + w1[i] * tm1 + w2[i] * z[i]);
                }
                if (m == 0 && fr < 2) { *(f32x4*)(side + ((size_t)blk * 6 + 2 + fr) * ldu + ch0) = z; *(f32x4*)(side + ((size_t)blk * 6 + 4 + fr) * ldu + ch0) = acc[ai][0][0][0]; }
                else { u32x2 w; w.x = cvt_pk_bf16(ya[0], ya[1]); w.y = cvt_pk_bf16(ya[2], ya[3]); *(u32x2*)(MX + row * ldm + ch0) = w; }
                if (m == 3 && fr >= 14) *(f32x4*)(side + ((size_t)blk * 6 + (fr - 14)) * ldu + ch0) = z;
                { const f32x4 uu = acc[ai][1][m][1]; u32x2 w; w.x = cvt_pk_bf16(uu[0], uu[1]); w.y = cvt_pk_bf16(uu[2], uu[3]); *(u32x2*)(U + row * ldu + ch0) = w; }
                zp = z;
            }
        }
    }
};

struct EpiGlu {
    static constexpr bool PERM = true, AFTER_DRAIN = false;
    const bf16_t* Gb; int ldg; bf16_t* O; int ldc; int ocol0;
    __device__ __forceinline__ void operator()(const f32x4 (&acc)[2][2][4][2], const Unit& u, int wr, int wc, int fr, int fq) const {
        const int row0 = u.pm * BM + wr * 64 + fr; const int col0 = u.pn * BM + wc * 32 + 8 * fq;
#pragma unroll
        for (int ai = 0; ai < 2; ++ai) {
            u32x4 gv[4][2];
#pragma unroll
            for (int m = 0; m < 4; ++m)
#pragma unroll
                for (int bj = 0; bj < 2; ++bj) gv[m][bj] = *(const u32x4*)(Gb + (size_t)(row0 + ai * HALF + m * 16) * ldg + col0 + bj * HALF);
            asm volatile("" : "+v"(gv[0][0]), "+v"(gv[0][1]), "+v"(gv[1][0]), "+v"(gv[1][1]), "+v"(gv[2][0]), "+v"(gv[2][1]), "+v"(gv[3][0]), "+v"(gv[3][1]));
#pragma unroll
            for (int m = 0; m < 4; ++m) { const size_t row = (size_t)(row0 + ai * HALF + m * 16);
#pragma unroll
                for (int bj = 0; bj < 2; ++bj) { const f32x4 v0 = acc[ai][bj][m][0], v1 = acc[ai][bj][m][1];
                    const u32x4 gq = gv[m][bj];
                    u32x4 w;
                    w.x = cvt_pk_bf16(bflo(gq.x) * sigmoidf_(v0[0]), bfhi(gq.x) * sigmoidf_(v0[1]));
                    w.y = cvt_pk_bf16(bflo(gq.y) * sigmoidf_(v0[2]), bfhi(gq.y) * sigmoidf_(v0[3]));
                    w.z = cvt_pk_bf16(bflo(gq.z) * sigmoidf_(v1[0]), bfhi(gq.z) * sigmoidf_(v1[1]));
                    w.w = cvt_pk_bf16(bflo(gq.w) * sigmoidf_(v1[2]), bfhi(gq.w) * sigmoidf_(v1[3]));
                    *(u32x4*)(O + row * ldc + ocol0 + col0 + bj * HALF) = w; } }
        }
    }
};
struct EpiRes {
    static constexpr bool PERM = true, AFTER_DRAIN = false;
    const float* resA; const float* resB; const bf16_t* resH; int split_row; bf16_t* out; int ldc; float alpha; float* slabs; size_t slab_stride;
    __device__ __forceinline__ void operator()(const f32x4 (&acc)[2][2][4][2], const Unit& u, int wr, int wc, int fr, int fq) const {
        const int row0 = u.pm * BM + wr * 64 + fr, col0 = u.pn * BM + wc * 32 + 8 * fq;
        if (u.slab >= 0) {
            float* sb = slabs + (size_t)u.slab * slab_stride + (size_t)(row0 - split_row) * ldc + col0;
#pragma unroll
            for (int ai = 0; ai < 2; ++ai)
#pragma unroll
                for (int m = 0; m < 4; ++m)
#pragma unroll
                    for (int bj = 0; bj < 2; ++bj)
#pragma unroll
                        for (int n = 0; n < 2; ++n) *(f32x4*)(sb + (size_t)(ai * HALF + m * 16) * ldc + bj * HALF + 4 * n) = acc[ai][bj][m][n];
            return;
        }
        bf16_t* ob = out + (size_t)row0 * ldc + col0;
        if (resH != nullptr) {
            const bf16_t* hb = resH + (size_t)row0 * ldc + col0;
#pragma unroll
            for (int ai = 0; ai < 2; ++ai) {
                u32x4 hq[4][2];
#pragma unroll
                for (int m = 0; m < 4; ++m)
#pragma unroll
                    for (int bj = 0; bj < 2; ++bj) hq[m][bj] = *(const u32x4*)(hb + (size_t)(ai * HALF + m * 16) * ldc + bj * HALF);
                asm volatile("" : "+v"(hq[0][0]), "+v"(hq[0][1]), "+v"(hq[1][0]), "+v"(hq[1][1]), "+v"(hq[2][0]), "+v"(hq[2][1]), "+v"(hq[3][0]), "+v"(hq[3][1]));
#pragma unroll
                for (int m = 0; m < 4; ++m) { const size_t ro = (size_t)(ai * HALF + m * 16) * ldc;
#pragma unroll
                    for (int bj = 0; bj < 2; ++bj) { const u32x4 hv = hq[m][bj];
                        const f32x4 r0 = {bflo(hv.x), bfhi(hv.x), bflo(hv.y), bfhi(hv.y)}, r1 = {bflo(hv.z), bfhi(hv.z), bflo(hv.w), bfhi(hv.w)};
                        const f32x4 o0 = r0 * alpha + acc[ai][bj][m][0], o1 = r1 * alpha + acc[ai][bj][m][1];
                        u32x4 w; w.x = cvt_pk_bf16(o0[0], o0[1]); w.y = cvt_pk_bf16(o0[2], o0[3]); w.z = cvt_pk_bf16(o1[0], o1[1]); w.w = cvt_pk_bf16(o1[2], o1[3]);
                        *(u32x4*)(ob + ro + bj * HALF) = w; } }
            }
            return;
        }
        const float* rbase = ((u.pm * BM < split_row) ? resA + (size_t)row0 * ldc : resB + (size_t)(row0 - split_row) * ldc) + col0;
#pragma unroll
        for (int ai = 0; ai < 2; ++ai)
#pragma unroll
            for (int mh = 0; mh < 2; ++mh) {
                f32x4 rq[2][2][2];
#pragma unroll
                for (int mm = 0; mm < 2; ++mm)
#pragma unroll
                    for (int bj = 0; bj < 2; ++bj) { const float* rp = rbase + (size_t)(ai * HALF + (2 * mh + mm) * 16) * ldc + bj * HALF; rq[mm][bj][0] = *(const f32x4*)rp; rq[mm][bj][1] = *(const f32x4*)(rp + 4); }
                asm volatile("" : "+v"(rq[0][0][0]), "+v"(rq[0][0][1]), "+v"(rq[0][1][0]), "+v"(rq[0][1][1]), "+v"(rq[1][0][0]), "+v"(rq[1][0][1]), "+v"(rq[1][1][0]), "+v"(rq[1][1][1]));
#pragma unroll
                for (int mm = 0; mm < 2; ++mm) { const int m = 2 * mh + mm; const size_t ro = (size_t)(ai * HALF + m * 16) * ldc;
#pragma unroll
                    for (int bj = 0; bj < 2; ++bj) {
                        const f32x4 o0 = rq[mm][bj][0] * alpha + acc[ai][bj][m][0], o1 = rq[mm][bj][1] * alpha + acc[ai][bj][m][1];
                        u32x4 w; w.x = cvt_pk_bf16(o0[0], o0[1]); w.y = cvt_pk_bf16(o0[2], o0[3]); w.z = cvt_pk_bf16(o1[0], o1[1]); w.w = cvt_pk_bf16(o1[2], o1[3]);
                        *(u32x4*)(ob + ro + bj * HALF) = w; } }
            }
    }
};

template <class Epi, class Sched, bool ALIGN_EPI = false, bool SP2 = false>
__device__ __forceinline__ void gemm_phase(PG8_LAS unsigned char* lds, const Gemm g, const Sched& S, const Epi& E) {
    int tid_ = threadIdx.x; asm volatile("" : "+v"(tid_));
    const int tid = tid_, wid = __builtin_amdgcn_readfirstlane(tid >> 6), lane = tid & 63, wr = wid >> 2, wc = wid & 3, fr = lane & 15, fq = lane >> 4;
    const int K = g.K;
    unsigned voffA[2], voffB[2];
#pragma unroll
    for (int i = 0; i < 2; ++i) { int R, C; stage_rc(tid * 16 + i * 8192, R, C); const int Rb = Epi::PERM ? ((R & ~31) + perm32(R & 31)) : R;
        voffA[i] = (unsigned)(R * K + C) * 2u; voffB[i] = (unsigned)(Rb * K + C) * 2u; }
    const size_t kstep = (size_t)(BK * 2);
    const size_t hstep = (size_t)HALF * K * 2;
    const size_t tstep = 2 * hstep;
    const unsigned ldsw = (unsigned)wid * 1024u;
    const int aoff = lds_byte(wr * 64 + fr, fq * 8), boff = lds_byte(wc * 32 + fr, fq * 8);
#define PG8_SA(b, h) (((b) * 2 + (h)) * HTB)
#define PG8_SB(b, h) ((4 + (b) * 2 + (h)) * HTB)
#define PG8_STAGE(bufoff, gbase, voff) do { _Pragma("unroll") for (int _i = 0; _i < 2; ++_i) \
        __builtin_amdgcn_global_load_lds((const unsigned*)((const char*)(gbase) + (voff)[_i]), (PG8_LAS unsigned*)(lds + (bufoff) + ldsw + _i * 8192), 16, 0, 0); } while (0)
#define PG8_LDA(dst, b, h) do { _Pragma("unroll") for (int m = 0; m < 4; ++m) _Pragma("unroll") for (int k = 0; k < 2; ++k) dst[m][k] = *(const PG8_LAS bf16x8*)(lds + PG8_SA(b, h) + aoff + m * 2048 + k * 1024); } while (0)
#define PG8_LDB(dst, b, h) do { _Pragma("unroll") for (int n = 0; n < 2; ++n) _Pragma("unroll") for (int k = 0; k < 2; ++k) dst[n][k] = *(const PG8_LAS bf16x8*)(lds + PG8_SB(b, h) + boff + n * 2048 + k * 1024); } while (0)
#define PG8_MMA(ai, bj, At, Bt) do { __builtin_amdgcn_s_setprio(1); _Pragma("unroll") for (int m = 0; m < 4; ++m) _Pragma("unroll") for (int n = 0; n < 2; ++n) _Pragma("unroll") for (int k = 0; k < 2; ++k) \
        acc[ai][bj][m][n] = __builtin_amdgcn_mfma_f32_16x16x32_bf16(Bt[n][k], At[m][k], acc[ai][bj][m][n], 0, 0, 0); __builtin_amdgcn_s_setprio(0); } while (0)
#define PG8_WAIT_V(n) asm volatile("s_waitcnt vmcnt(" #n ")" ::: "memory")
#define PG8_WAIT_L(n) asm volatile("s_waitcnt lgkmcnt(" #n ")" ::: "memory")
#define PG8_BAR __builtin_amdgcn_s_barrier()
#define PG8_SCHED __builtin_amdgcn_sched_barrier(0)
    Unit cur, nxt; int ui = 0;
    if (!S.next(0, cur)) return;
    f32x4 acc[2][2][4][2];
#pragma unroll
    for (int a = 0; a < 2; ++a)
#pragma unroll
        for (int b = 0; b < 2; ++b)
#pragma unroll
            for (int m = 0; m < 4; ++m)
#pragma unroll
                for (int n = 0; n < 2; ++n) acc[a][b][m][n] = (f32x4){0.f, 0.f, 0.f, 0.f};
    bf16x8 At[4][2], B0[2][2], B1[2][2];
    const char* cA = (const char*)g.A + (size_t)cur.pm * tstep + (size_t)cur.k0 * kstep; const char* cB = (const char*)g.Bt + (size_t)cur.pn * tstep + (size_t)cur.k0 * kstep;
    S.a_ready(cur);
    if constexpr (SP2) {
        PG8_STAGE(PG8_SB(0, 0), cB, voffB); PG8_STAGE(PG8_SB(0, 1), cB + hstep, voffB); PG8_STAGE(PG8_SA(0, 0), cA, voffA); PG8_STAGE(PG8_SA(0, 1), cA + hstep, voffA);
        if (wr == 1) PG8_BAR;
        PG8_WAIT_V(2); PG8_BAR;
        PG8_STAGE(PG8_SB(1, 0), cB + kstep, voffB); PG8_STAGE(PG8_SA(1, 0), cA + kstep, voffA); PG8_STAGE(PG8_SB(1, 1), cB + hstep + kstep, voffB);
        PG8_WAIT_V(6); PG8_BAR;
    } else {
        PG8_STAGE(PG8_SB(0, 0), cB, voffB); PG8_STAGE(PG8_SA(0, 0), cA, voffA); PG8_STAGE(PG8_SB(0, 1), cB + hstep, voffB); PG8_STAGE(PG8_SA(0, 1), cA + hstep, voffA);
        if (wr == 1) PG8_BAR;
        PG8_WAIT_V(4); PG8_BAR;
        PG8_STAGE(PG8_SB(1, 0), cB + kstep, voffB); PG8_STAGE(PG8_SA(1, 0), cA + kstep, voffA); PG8_STAGE(PG8_SB(1, 1), cB + hstep + kstep, voffB);
        PG8_WAIT_V(6); PG8_BAR;
    }
    for (;;) {
        const bool has_next = S.next(ui + 1, nxt);
        const char* nA = has_next ? (const char*)g.A + (size_t)nxt.pm * tstep + (size_t)nxt.k0 * kstep : cA; const char* nB = has_next ? (const char*)g.Bt + (size_t)nxt.pn * tstep + (size_t)nxt.k0 * kstep : cB;
        const int nt = cur.nt;
        for (int t = 0; t < nt; t += 2) {
            const bool last = (t == nt - 2);
            const char* a1 = cA + (size_t)(t + 1) * kstep;
            const char* a2 = last ? nA : cA + (size_t)(t + 2) * kstep; const char* b2 = last ? nB : cB + (size_t)(t + 2) * kstep;
            const char* a3 = a2 + kstep; const char* b3 = b2 + kstep;
            if (last && has_next) S.a_ready(nxt);
            if constexpr (SP2) {
            PG8_LDB(B0, 0, 0); PG8_LDB(B1, 0, 1); PG8_SCHED; PG8_LDA(At, 0, 0); PG8_STAGE(PG8_SA(1, 1), a1 + hstep, voffA);
            PG8_WAIT_V(8); PG8_WAIT_L(0); PG8_BAR; PG8_MMA(0, 0, At, B0); PG8_MMA(0, 1, At, B1); PG8_BAR; PG8_SCHED;
            PG8_LDA(At, 0, 1); PG8_STAGE(PG8_SB(0, 0), b2, voffB); PG8_STAGE(PG8_SB(0, 1), b2 + hstep, voffB); PG8_STAGE(PG8_SA(0, 0), a2, voffA);
            PG8_WAIT_V(8); PG8_WAIT_L(0); PG8_BAR; PG8_MMA(1, 0, At, B0); PG8_MMA(1, 1, At, B1); PG8_BAR; PG8_SCHED;
            PG8_LDB(B0, 1, 0); PG8_LDB(B1, 1, 1); PG8_SCHED; PG8_LDA(At, 1, 0); PG8_STAGE(PG8_SA(0, 1), a2 + hstep, voffA);
            PG8_WAIT_V(8); PG8_WAIT_L(0); PG8_BAR; PG8_MMA(0, 0, At, B0); PG8_MMA(0, 1, At, B1); PG8_BAR; PG8_SCHED;
            PG8_LDA(At, 1, 1); PG8_STAGE(PG8_SB(1, 0), b3, voffB); PG8_STAGE(PG8_SB(1, 1), b3 + hstep, voffB); PG8_STAGE(PG8_SA(1, 0), a3, voffA);
            PG8_WAIT_V(8); PG8_WAIT_L(0); PG8_BAR; PG8_MMA(1, 0, At, B0); PG8_MMA(1, 1, At, B1); PG8_BAR; PG8_SCHED;
            } else {
            PG8_LDB(B0, 0, 0); PG8_SCHED; PG8_LDA(At, 0, 0); PG8_STAGE(PG8_SA(1, 1), a1 + hstep, voffA);
            PG8_WAIT_L(8); PG8_BAR; PG8_WAIT_L(0); PG8_MMA(0, 0, At, B0); PG8_BAR; PG8_SCHED;
            PG8_LDB(B1, 0, 1); PG8_STAGE(PG8_SB(0, 0), b2, voffB);
            PG8_BAR; PG8_WAIT_L(0); PG8_MMA(0, 1, At, B1); PG8_BAR;
            PG8_LDA(At, 0, 1); PG8_STAGE(PG8_SA(0, 0), a2, voffA);
            PG8_BAR; PG8_WAIT_L(0); PG8_MMA(1, 0, At, B0); PG8_BAR; PG8_SCHED;
            PG8_STAGE(PG8_SB(0, 1), b2 + hstep, voffB);
            PG8_WAIT_V(6); PG8_BAR; PG8_MMA(1, 1, At, B1); PG8_BAR;
            PG8_LDB(B0, 1, 0); PG8_SCHED; PG8_LDA(At, 1, 0); PG8_STAGE(PG8_SA(0, 1), a2 + hstep, voffA);
            PG8_WAIT_L(8); PG8_BAR; PG8_WAIT_L(0); PG8_MMA(0, 0, At, B0); PG8_BAR; PG8_SCHED;
            PG8_LDB(B1, 1, 1); PG8_STAGE(PG8_SB(1, 0), b3, voffB);
            PG8_BAR; PG8_WAIT_L(0); PG8_MMA(0, 1, At, B1); PG8_BAR;
            PG8_LDA(At, 1, 1); PG8_STAGE(PG8_SA(1, 0), a3, voffA);
            PG8_BAR; PG8_WAIT_L(0); PG8_MMA(1, 0, At, B0); PG8_BAR; PG8_SCHED;
            PG8_STAGE(PG8_SB(1, 1), b3 + hstep, voffB);
            PG8_WAIT_V(6); PG8_BAR; PG8_MMA(1, 1, At, B1); PG8_BAR;
            }
        }
        if constexpr (ALIGN_EPI) { if (wr == 0) PG8_BAR; }
        if constexpr (!Epi::AFTER_DRAIN) { E(acc, cur, wr, wc, fr, fq); S.done(cur); }
        if (!has_next) break;
#pragma unroll
        for (int a = 0; a < 2; ++a)
#pragma unroll
            for (int b = 0; b < 2; ++b)
#pragma unroll
                for (int m = 0; m < 4; ++m)
#pragma unroll
                    for (int n = 0; n < 2; ++n) acc[a][b][m][n] = (f32x4){0.f, 0.f, 0.f, 0.f};
        cur = nxt; cA = nA; cB = nB; ++ui;
        if constexpr (ALIGN_EPI) { if (wr == 1) PG8_BAR; }
    }
    PG8_WAIT_V(0);
    if constexpr (!ALIGN_EPI) { if (wr == 0) PG8_BAR; }
    PG8_BAR;
    if constexpr (Epi::AFTER_DRAIN) { E.fused(acc, cur, wr, wc, fr, fq, lds, wid, lane); S.done(cur); }
#undef PG8_SA
#undef PG8_SB
#undef PG8_STAGE
#undef PG8_LDA
#undef PG8_LDB
#undef PG8_MMA
#undef PG8_WAIT_V
#undef PG8_WAIT_L
#undef PG8_BAR
#undef PG8_SCHED
}
}
#define XB_TMO      128
#define XB_XCNT(j)  (256  + 64 * (j))
#define XB_XSUB(j)  (1280 + 64 * (j))
#define XB_XGEN(j)  (2304 + 64 * (j))
#define XB_TOP      3328
#define XB_TOPGEN   3392
#define XCD_BAR_WORDS 3456
#define XB_SPIN_CAP (1u << 18)
#define LAS __attribute__((address_space(3)))

__device__ __forceinline__ unsigned xb_ld(unsigned* p)              { return __hip_atomic_load(p, __ATOMIC_RELAXED, __HIP_MEMORY_SCOPE_AGENT); }
__device__ __forceinline__ unsigned xb_add(unsigned* p, unsigned v) { return __hip_atomic_fetch_add(p, v, __ATOMIC_RELAXED, __HIP_MEMORY_SCOPE_AGENT); }
__device__ __forceinline__ unsigned xb_xcc_id() { return (unsigned)__builtin_amdgcn_s_getreg((3 << 11) | 20) & 0xFu; }
#define XB_SPIN(cond, bar) do { unsigned _sp = 0; while (cond) { __builtin_amdgcn_s_sleep(1); \
    if ((++_sp & 255u) == 0u) { if (xb_ld(&(bar)[XB_TMO])) break; if (_sp > XB_SPIN_CAP) { atomicAdd(&(bar)[XB_TMO], 1u); break; } } } } while (0)

struct XcdBarrier {
    unsigned* bar; unsigned x;
    volatile LAS unsigned* st;
};

__device__ __forceinline__ XcdBarrier xcd_barrier_post(unsigned* bar, volatile LAS unsigned* st) {
    XcdBarrier b; b.bar = bar; b.x = xb_xcc_id(); b.st = st;
    if (threadIdx.x == 0) (void)xb_add(&bar[XB_XCNT(b.x)], 1u);
    return b;
}
__device__ __forceinline__ void xcd_barrier_complete(unsigned* bar, unsigned x, unsigned& nloc, unsigned& nx) {
    const unsigned G = gridDim.x * gridDim.y * gridDim.z;
    unsigned sum, cnt, mine, sp = 0u; unsigned cc[16];
    for (;;) {
        sum = 0u; cnt = 0u; mine = 0u;
#pragma unroll
        for (unsigned j = 0; j < 16; ++j) cc[j] = xb_ld(&bar[XB_XCNT(j)]);
        asm volatile("" : "+v"(cc[0]), "+v"(cc[1]), "+v"(cc[2]), "+v"(cc[3]), "+v"(cc[4]), "+v"(cc[5]), "+v"(cc[6]), "+v"(cc[7]), "+v"(cc[8]), "+v"(cc[9]), "+v"(cc[10]), "+v"(cc[11]), "+v"(cc[12]), "+v"(cc[13]), "+v"(cc[14]), "+v"(cc[15]));
#pragma unroll
        for (unsigned j = 0; j < 16; ++j) { const unsigned c = cc[j]; sum += c; cnt += (c > 0u) ? 1u : 0u; mine = (j == x) ? c : mine; }
        if (sum == G) break;
        __builtin_amdgcn_s_sleep(1);
        if ((++sp & 255u) == 0u) { if (xb_ld(&bar[XB_TMO])) break; if (sp > XB_SPIN_CAP) { atomicAdd(&bar[XB_TMO], 1u); break; } }
    }
    nloc = mine > 0u ? mine : 1u; nx = cnt > 0u ? cnt : 1u;
}

__device__ __forceinline__ void xcd_barrier(const XcdBarrier& b) {
    asm volatile("s_waitcnt vmcnt(0)" ::: "memory");
    __syncthreads();
    if (threadIdx.x == 0) {
        unsigned* bar = b.bar;
        __builtin_amdgcn_s_waitcnt(0);
        unsigned nloc = b.st[0], nx = b.st[1];
        if (nloc == 0u) { xcd_barrier_complete(bar, b.x, nloc, nx); b.st[0] = nloc; b.st[1] = nx; }
        const unsigned old = xb_add(&bar[XB_XSUB(b.x)], 1u);
        const unsigned gen = old / nloc;
        if (old + 1u == (gen + 1u) * nloc) {
            __builtin_amdgcn_fence(__ATOMIC_RELEASE, "agent");
            asm volatile("s_waitcnt vmcnt(0)" ::: "memory");
            const unsigned og = xb_add(&bar[XB_TOP], 1u);
            const unsigned tg = og / nx;
            if (og + 1u == (tg + 1u) * nx) xb_add(&bar[XB_TOPGEN], 1u);
            else XB_SPIN(xb_ld(&bar[XB_TOPGEN]) == tg, bar);
            __builtin_amdgcn_fence(__ATOMIC_ACQUIRE, "agent");
            xb_add(&bar[XB_XGEN(b.x)], 1u);
            asm volatile("s_waitcnt vmcnt(0)" ::: "memory");
        } else {
            XB_SPIN(xb_ld(&bar[XB_XGEN(b.x)]) == gen, bar);
            __builtin_amdgcn_fence(__ATOMIC_ACQUIRE, "agent");
            asm volatile("s_waitcnt vmcnt(0)" ::: "memory");
        }
    }
    __syncthreads();
}

constexpr int D = 4096, NPROJ = 8192, CW = 2048, SW = 2048, NG = 128, NP = 64, DFF = 11008, NAV = 2 * DFF;
constexpr int TP = 16384, NSB = 8, TSQ = 64, M = TP + NSB * TSQ;
constexpr int NCHP = TP / 64, NCH = NCHP + NSB;
constexpr float LN_EPS = 1e-5f, ALPHA = 1.41421356237309515f;
constexpr int NPH = 11;
constexpr size_t O_Y = 0, O_CONV_P = 69206016, O_RE_P = 69214208, O_IM_P = 69230592, O_FFN_P = 69246976, O_CONV_S = 69291008, O_RE_S = 69356544, O_IM_S = 69487616, O_FFN_S = 69618688, OUT_TOTAL = 69970944;
constexpr size_t MiB = 1u << 20;
constexpr size_t WS_CTL = 0, CTL_ZERO_BYTES = 1 * MiB;
constexpr size_t WS_LB = 1 * MiB, WS_LB64 = WS_LB + 65536, WS_BBH = WS_LB64 + 65536, WS_CF = WS_BBH + 524288;
constexpr size_t WS_E = 3 * MiB, WS_HS = 19 * MiB;
constexpr size_t WS_WIN = 36 * MiB, WS_WGLU = 100 * MiB, WS_WOUT = 108 * MiB, WS_WAV = 140 * MiB, WS_WDN = 312 * MiB;
constexpr size_t WS_XB = 398 * MiB, WS_BIG = 794 * MiB, WS_END = 1504 * MiB;
constexpr size_t WS2_WIN = 530 * MiB, WS2_WGLU = 594 * MiB, WS2_WOUT = 602 * MiB, WS2_WDN = 634 * MiB, WS2_WAV = 1504 * MiB, WS_END2 = 1676 * MiB;
__device__ __forceinline__ size_t w_off(int which, bool second) {
    return which == 0 ? (second ? WS2_WIN : WS_WIN) : which == 1 ? (second ? WS2_WGLU : WS_WGLU) : which == 2 ? (second ? WS2_WOUT : WS_WOUT) : which == 3 ? (second ? WS2_WAV : WS_WAV) : (second ? WS2_WDN : WS_WDN); }
constexpr int CV_IN = 16384, CV_G1 = 34816, CV_G2 = 46336, CV_AV = 70656, CV_ALL = 92672, CV_NEXT = 8512;
constexpr size_t BIG_U = 0, BIG_SIDE2 = 66 * MiB, BIG_G = 264 * MiB;
constexpr size_t BIG_MIX = 330 * MiB, BIG_R = 0, BIG_A = 0, BIG_V = 355 * MiB;
constexpr size_t BIG_SLAB1 = 462 * MiB, BIG_SLAB2 = 264 * MiB, BIG_SIDE = 0;
static_assert((size_t)M * DFF * 2 <= 355 * MiB && BIG_V + (size_t)M * DFF * 2 <= WS_END - WS_BIG, "ws map");
constexpr int CW_BAR = 4096;
constexpr int RING_BYTES = 131072, LDSCTL_OFF = RING_BYTES, LDS_BYTES = 147456;

#define LAS __attribute__((address_space(3)))
typedef unsigned short bf16;
typedef unsigned u32x4 __attribute__((ext_vector_type(4)));
typedef unsigned u32x2 __attribute__((ext_vector_type(2)));
typedef float f32x4 __attribute__((ext_vector_type(4)));
typedef float f32x2 __attribute__((ext_vector_type(2)));
typedef float f32x16 __attribute__((ext_vector_type(16)));
typedef short bf16x8 __attribute__((ext_vector_type(8)));
#define LDS_WAIT() asm volatile("s_waitcnt lgkmcnt(0)" ::: "memory")
using pg8::cvt_pk_bf16; using pg8::bflo; using pg8::bfhi; using pg8::sigmoidf_;

__device__ __forceinline__ unsigned long long ldc8(const void* p) { return __hip_atomic_load((const unsigned long long*)p, __ATOMIC_RELAXED, __HIP_MEMORY_SCOPE_AGENT); }
__device__ __forceinline__ f32x2 ldc_f2(const void* p) { const unsigned long long w = ldc8(p); return (f32x2){__uint_as_float((unsigned)w), __uint_as_float((unsigned)(w >> 32))}; }
__device__ __forceinline__ bf16x8 ldc_frag(const void* p) { const unsigned long long a = ldc8(p), b = ldc8((const char*)p + 8); u32x4 w = {(unsigned)a, (unsigned)(a >> 32), (unsigned)b, (unsigned)(b >> 32)}; return __builtin_bit_cast(bf16x8, w); }
struct Args { const float* in[26]; float* out; unsigned char* ws; int ph_lo, ph_hi, w2, pad; };

__device__ __forceinline__ void transpose_item(const float* __restrict__ W, int K, int N, bf16* __restrict__ WT, int row_off, LAS float* scr, int item, int lane, int ilv = 0) {
    const int nblk = N / 32, kb = item / nblk, nb = item - kb * nblk, k0 = 64 * kb, n0 = 32 * nb;
    const int orow = (ilv == 1 || ilv == 2) ? (((n0 >> 7) << 8) + (n0 & 127) + (ilv == 2 ? 128 : 0)) : row_off + n0;
    const float* src = W + (size_t)(k0 + (lane >> 5)) * N + n0 + (lane & 31);
    float v[32];
#pragma unroll
    for (int i = 0; i < 32; ++i) v[i] = src[(size_t)(2 * i) * N];
#pragma unroll
    for (int i = 0; i < 32; ++i) scr[(2 * i + (lane >> 5)) * 33 + (lane & 31)] = v[i];
    LDS_WAIT();
    const int c = lane & 7;
#pragma unroll
    for (int j = 0; j < 4; ++j) { const int n = (lane >> 3) + 8 * j; const LAS float* s = scr + (8 * c) * 33 + n;
        u32x4 o; o.x = cvt_pk_bf16(s[0 * 33], s[1 * 33]); o.y = cvt_pk_bf16(s[2 * 33], s[3 * 33]); o.z = cvt_pk_bf16(s[4 * 33], s[5 * 33]); o.w = cvt_pk_bf16(s[6 * 33], s[7 * 33]);
        int orw = orow + n;
        if (ilv == 3) { const int sc = n0 + n, ty = sc >> 11, ch = sc & 2047, cl = ch & 63; orw = ((ch >> 6) << 8) + ((ty >> 1) << 7) + ((cl >> 4) << 5) + (((cl >> 2) & 3) << 3) + ((ty & 1) << 2) + (cl & 3); }
        *(u32x4*)(WT + (size_t)orw * K + k0 + 8 * c) = o; }
    LDS_WAIT();
}

__device__ __forceinline__ void convert_items(const Args& a, int layer, bool second, LAS unsigned char* L, int lo, int hi, int iw, int niw, int lane, int wave) {
    unsigned char* ws = a.ws; asm volatile("" : "+s"(ws));
    LAS float* scr = (LAS float*)(L + wave * 16384);
    constexpr int I_IN = (D / 64) * (NPROJ / 32), I_GLU = (SW / 64) * (SW / 32), I_OUT = (D / 64) * (D / 32), I_A = (D / 64) * (DFF / 32), I_DN = (DFF / 64) * (D / 32);
    constexpr int NITEMS = I_IN + I_GLU + I_OUT + 2 * I_A + I_DN;
    static_assert(CV_ALL == NITEMS && CV_IN == I_IN && CV_AV == I_IN + I_GLU + I_OUT + 2 * I_A, "conversion slices");
    if (hi > NITEMS) hi = NITEMS;
    const float* w_in = a.in[6] + (size_t)layer * D * NPROJ; const float* w_glu = a.in[16] + (size_t)layer * SW * SW; const float* w_out = a.in[17] + (size_t)layer * D * D;
    const float* w_a = a.in[20] + (size_t)layer * D * DFF; const float* w_v = a.in[21] + (size_t)layer * D * DFF; const float* w_dn = a.in[23] + (size_t)layer * DFF * D;
    for (int it = lo + iw; it < hi; it += niw) {
        int r = it;
        if (r < I_IN) { transpose_item(w_in, D, NPROJ, (bf16*)(ws + w_off(0, second)), 0, scr, r, lane, 3); continue; } r -= I_IN;
        if (r < I_GLU) { transpose_item(w_glu, SW, SW, (bf16*)(ws + w_off(1, second)), 0, scr, r, lane); continue; } r -= I_GLU;
        if (r < I_OUT) { transpose_item(w_out, D, D, (bf16*)(ws + w_off(2, second)), 0, scr, r, lane); continue; } r -= I_OUT;
        if (r < I_A) { transpose_item(w_a, D, DFF, (bf16*)(ws + w_off(3, second)), 0, scr, r, lane, 1); continue; } r -= I_A;
        if (r < I_A) { transpose_item(w_v, D, DFF, (bf16*)(ws + w_off(3, second)), 0, scr, r, lane, 2); continue; } r -= I_A;
        transpose_item(w_dn, DFF, D, (bf16*)(ws + w_off(4, second)), 0, scr, r, lane);
    }
}
__device__ __forceinline__ void all_convert(const Args& a, int layer, LAS unsigned char* L, int lo, int hi) {
    int t_ = threadIdx.x; asm volatile("" : "+v"(t_)); const int tid = t_, lane = tid & 63, wave = __builtin_amdgcn_readfirstlane(tid >> 6);
    convert_items(a, layer, false, L, lo, hi, (int)blockIdx.x * 8 + wave, (int)gridDim.x * 8, lane, wave);
}
__device__ __forceinline__ void tail_convert(const Args& a, int layer, LAS unsigned char* L, int rem, int lo, int hi) {
    int t_ = threadIdx.x; asm volatile("" : "+v"(t_)); const int tid = t_, lane = tid & 63, wave = __builtin_amdgcn_readfirstlane(tid >> 6);
    if ((int)blockIdx.x < rem) return;
    convert_items(a, layer, false, L, lo, hi, ((int)blockIdx.x - rem) * 8 + wave, ((int)gridDim.x - rem) * 8, lane, wave);
}

__device__ __forceinline__ void phase0(const Args& a, int layer, LAS unsigned char* L) {
    int t_ = threadIdx.x; asm volatile("" : "+v"(t_)); const int tid = t_, lane = tid & 63, wave = __builtin_amdgcn_readfirstlane(tid >> 6); (void)lane; (void)wave;
    unsigned char* ws = a.ws; asm volatile("" : "+s"(ws));
    const int gtid = blockIdx.x * 512 + tid, NT = gridDim.x * 512;
    if (gtid < NG * NP) {
        const int g = gtid >> 6, p = gtid & 63;
        const float dt = expf(a.in[10][layer * NG + g]);
        const float are = a.in[8][layer * NG * NP + gtid], aim = a.in[9][layer * NG * NP + gtid];
        const float mag = expf(are * dt), ang = aim * dt;
        const float lr = mag * cosf(ang), li = mag * sinf(ang);
        const float nr = lr - 1.0f, ni = li, den = are * are + aim * aim;
        const float cr = (nr * are + ni * aim) / den, ci = (ni * are - nr * aim) / den;
        float pr = lr, pi = li;
#pragma unroll
        for (int s = 0; s < 6; ++s) { const float tr = pr * pr - pi * pi, ti = 2.0f * pr * pi; pr = tr; pi = ti; }
        ((f32x2*)(ws + WS_LB))[gtid] = (f32x2){lr, li};
        ((f32x2*)(ws + WS_LB64))[gtid] = (f32x2){pr, pi};
        bf16* BBh = (bf16*)(ws + WS_BBH); bf16* CF = (bf16*)(ws + WS_CF);
        const float* bre_ = a.in[11] + ((size_t)layer * NG * NP + gtid) * 16; const float* bim_ = a.in[12] + ((size_t)layer * NG * NP + gtid) * 16;
        const float* cre = a.in[13] + (size_t)layer * NG * 16 * NP + (size_t)g * 16 * NP + p; const float* cim = a.in[14] + (size_t)layer * NG * 16 * NP + (size_t)g * 16 * NP + p;
        f32x4 bq[8]; float cq[32];
#pragma unroll
        for (int i = 0; i < 4; ++i) { bq[i] = ((const f32x4*)bre_)[i]; bq[4 + i] = ((const f32x4*)bim_)[i]; }
#pragma unroll
        for (int c = 0; c < 16; ++c) { cq[c] = cre[c * NP]; cq[16 + c] = cim[c * NP]; }
        asm volatile("" : "+v"(bq[0]), "+v"(bq[1]), "+v"(bq[2]), "+v"(bq[3]), "+v"(bq[4]), "+v"(bq[5]), "+v"(bq[6]), "+v"(bq[7]));
        asm volatile("" : "+v"(cq[0]), "+v"(cq[1]), "+v"(cq[2]), "+v"(cq[3]), "+v"(cq[4]), "+v"(cq[5]), "+v"(cq[6]), "+v"(cq[7]), "+v"(cq[8]), "+v"(cq[9]), "+v"(cq[10]), "+v"(cq[11]), "+v"(cq[12]), "+v"(cq[13]), "+v"(cq[14]), "+v"(cq[15]));
        asm volatile("" : "+v"(cq[16]), "+v"(cq[17]), "+v"(cq[18]), "+v"(cq[19]), "+v"(cq[20]), "+v"(cq[21]), "+v"(cq[22]), "+v"(cq[23]), "+v"(cq[24]), "+v"(cq[25]), "+v"(cq[26]), "+v"(cq[27]), "+v"(cq[28]), "+v"(cq[29]), "+v"(cq[30]), "+v"(cq[31]));
#pragma unroll
        for (int c = 0; c < 16; c += 2) {
            const float br0 = bq[c >> 2][c & 3], bi0 = bq[4 + (c >> 2)][c & 3], br1 = bq[(c + 1) >> 2][(c + 1) & 3], bi1 = bq[4 + ((c + 1) >> 2)][(c + 1) & 3];
            const unsigned wre = cvt_pk_bf16(cr * br0 - ci * bi0, cr * br1 - ci * bi1), wim = cvt_pk_bf16(cr * bi0 + ci * br0, cr * bi1 + ci * br1);
            const int ln = (c >> 3) * 32 + (p & 31), j = c & 7;
            *(unsigned*)(BBh + ((size_t)(g * 4 + (p >> 5)) * 64 + ln) * 8 + j) = wre;
            *(unsigned*)(BBh + ((size_t)(g * 4 + 2 + (p >> 5)) * 64 + ln) * 8 + j) = wim;
        }
#pragma unroll
        for (int c = 0; c < 16; ++c) {
            const unsigned w = cvt_pk_bf16(cq[c], -cq[16 + c]);
            const int kk = p >> 4, q = (p & 15) >> 2, ln = q * 16 + c, j0 = 2 * (p & 3);
            *(unsigned*)(CF + ((size_t)(g * 4 + kk) * 64 + ln) * 8 + j0) = w;
        }
    }
    if (layer == 0) {
        u32x4* xb = (u32x4*)(ws + WS_XB);
        const size_t n8 = (size_t)M * D / 8, np8 = (size_t)TP * D / 8;
        size_t i = gtid;
        for (; i + 3 * (size_t)NT < n8; i += 4 * (size_t)NT) {
            f32x4 q[4][2];
#pragma unroll
            for (int u = 0; u < 4; ++u) { const size_t ii = i + (size_t)u * NT; const f32x4* s = (ii < np8) ? (const f32x4*)a.in[0] + 2 * ii : (const f32x4*)a.in[1] + 2 * (ii - np8); q[u][0] = s[0]; q[u][1] = s[1]; }
            asm volatile("" : "+v"(q[0][0]), "+v"(q[0][1]), "+v"(q[1][0]), "+v"(q[1][1]), "+v"(q[2][0]), "+v"(q[2][1]), "+v"(q[3][0]), "+v"(q[3][1]));
#pragma unroll
            for (int u = 0; u < 4; ++u) { const f32x4 v0 = q[u][0], v1 = q[u][1];
                u32x4 o; o.x = cvt_pk_bf16(v0[0], v0[1]); o.y = cvt_pk_bf16(v0[2], v0[3]); o.z = cvt_pk_bf16(v1[0], v1[1]); o.w = cvt_pk_bf16(v1[2], v1[3]);
                xb[i + (size_t)u * NT] = o; }
        }
        for (; i < n8; i += NT) {
            const f32x4* s = (i < np8) ? (const f32x4*)a.in[0] + 2 * i : (const f32x4*)a.in[1] + 2 * (i - np8);
            const f32x4 v0 = s[0], v1 = s[1];
            u32x4 o; o.x = cvt_pk_bf16(v0[0], v0[1]); o.y = cvt_pk_bf16(v0[2], v0[3]); o.z = cvt_pk_bf16(v1[0], v1[1]); o.w = cvt_pk_bf16(v1[2], v1[3]);
            xb[i] = o;
        }
    }
    convert_items(a, layer, false, L, (layer == 1 && gridDim.x == 256) ? CV_NEXT : 0, gridDim.x == 256 ? CV_IN : CV_ALL, blockIdx.x * 8 + wave, gridDim.x * 8, lane, wave);
}

#define S5_BU(afrag) \
    f32x16 xr_ = __builtin_amdgcn_mfma_f32_32x32x16_bf16(afrag, Bf[0], z16, 0, 0, 0), yr_ = __builtin_amdgcn_mfma_f32_32x32x16_bf16(afrag, Bf[1], z16, 0, 0, 0); \
    f32x16 xi_ = __builtin_amdgcn_mfma_f32_32x32x16_bf16(afrag, Bf[2], z16, 0, 0, 0), yi_ = __builtin_amdgcn_mfma_f32_32x32x16_bf16(afrag, Bf[3], z16, 0, 0, 0); \
    float bur[2][16], bui[2][16]; \
    _Pragma("unroll") for (int r = 0; r < 16; ++r) { \
        auto sr_ = __builtin_amdgcn_permlane32_swap(__float_as_uint(xr_[r]), __float_as_uint(yr_[r]), false, false); bur[0][r] = __uint_as_float(sr_[0]); bur[1][r] = __uint_as_float(sr_[1]); \
        auto si_ = __builtin_amdgcn_permlane32_swap(__float_as_uint(xi_[r]), __float_as_uint(yi_[r]), false, false); bui[0][r] = __uint_as_float(si_[0]); bui[1][r] = __uint_as_float(si_[1]); }

__device__ __forceinline__ void s5_pass_a(unsigned char* ws_) {
    size_t wz_ = 0; asm volatile("" : "+s"(wz_)); unsigned char* ws = ws_ + wz_;
    int t_ = threadIdx.x; asm volatile("" : "+v"(t_)); const int tid = t_, lane = tid & 63, wave = __builtin_amdgcn_readfirstlane(tid >> 6); (void)lane; (void)wave;
    const int gw = blockIdx.x * 8 + wave, g = gw & 127, s0 = gw >> 7, ns = (gridDim.x * 8) >> 7;
    if (ns == 0) return;
    const int cps = (NCHP + ns - 1) / ns, kb = s0 * cps, ke = (kb + cps < NCHP) ? kb + cps : NCHP;
    if (s0 >= ns - 1 || kb >= ke) return;
    const bf16* U = (const bf16*)(ws + WS_BIG + BIG_U);
    bf16x8 Bf[4];
#pragma unroll
    for (int j = 0; j < 4; ++j) Bf[j] = ldc_frag((const bf16*)(ws + WS_BBH) + ((size_t)(g * 4 + j) * 64 + lane) * 8);
    const f32x2 lb = ldc_f2((const f32x2*)(ws + WS_LB) + g * 64 + lane);
    const float lr = lb.x, li = lb.y;
    f32x16 z16;
#pragma unroll
    for (int i = 0; i < 16; ++i) z16[i] = 0.f;
    const size_t loff = (size_t)(lane & 31) * SW + 16 * g + 8 * (lane >> 5);
    bf16x8 a0, a1;
    { const bf16* up = U + (size_t)kb * 64 * SW + loff; a0 = *(const bf16x8*)up; a1 = *(const bf16x8*)(up + (size_t)32 * SW); }
    float hr = 0.f, hi = 0.f;
    for (int k = kb; k < ke; ++k) {
        bf16x8 n0 = a0, n1 = a1;
        if (k + 1 < ke) { const bf16* up = U + (size_t)(k + 1) * 64 * SW + loff; n0 = *(const bf16x8*)up; n1 = *(const bf16x8*)(up + (size_t)32 * SW); }
#pragma unroll
        for (int rt = 0; rt < 2; ++rt) {
            const bf16x8 af = rt ? a1 : a0;
            S5_BU(af)
#pragma unroll
            for (int aa = 0; aa < 4; ++aa)
#pragma unroll
                for (int h = 0; h < 2; ++h)
#pragma unroll
                    for (int i = 0; i < 4; ++i) { const int r = 4 * aa + i; const float tr = lr * hr - li * hi + bur[h][r], ti = lr * hi + li * hr + bui[h][r]; hr = tr; hi = ti; }
        }
        a0 = n0; a1 = n1;
    }
    ((f32x2*)(ws + WS_E))[(size_t)s0 * (NG * NP) + g * 64 + lane] = (f32x2){hr, hi};
}
__device__ __forceinline__ int s5_row0(int i, int nr, int kb, int s0, int ns) { return (i < nr) ? (kb + i) * 64 : TP + (s0 + (i - nr) * ns) * 64; }
__device__ __forceinline__ void s5_pass_c(const Args& a, int layer, LAS unsigned char* L) {
    int t_ = threadIdx.x; asm volatile("" : "+v"(t_)); const int tid = t_, lane = tid & 63, wave = __builtin_amdgcn_readfirstlane(tid >> 6); (void)lane; (void)wave;
    size_t wz_ = 0; asm volatile("" : "+s"(wz_)); unsigned char* ws = a.ws + wz_;
    const int gw = blockIdx.x * 8 + wave, g = gw & 127, s0 = gw >> 7, ns = (gridDim.x * 8) >> 7;
    if (ns == 0) return;
    const int cps = (NCHP + ns - 1) / ns, kb = s0 * cps, ke = (kb + cps < NCHP) ? kb + cps : NCHP;
    const int nr = ke > kb ? ke - kb : 0, nsm = (s0 < NSB) ? (NSB - 1 - s0) / ns + 1 : 0, cnt = nr + nsm;
    if (cnt == 0) return;
    const bf16* U = (const bf16*)(ws + WS_BIG + BIG_U); bf16* Gb = (bf16*)(ws + WS_BIG + BIG_G);
    bf16x8 Bf[4], Cf[4];
#pragma unroll
    for (int j = 0; j < 4; ++j) { Bf[j] = ldc_frag((const bf16*)(ws + WS_BBH) + ((size_t)(g * 4 + j) * 64 + lane) * 8); Cf[j] = ldc_frag((const bf16*)(ws + WS_CF) + ((size_t)(g * 4 + j) * 64 + lane) * 8); }
    const f32x2 lb = ldc_f2((const f32x2*)(ws + WS_LB) + g * 64 + lane);
    const float lr = lb.x, li = lb.y;
    const f32x4 dsk = *(const f32x4*)(a.in[15] + (size_t)layer * SW + 16 * g + 4 * (lane >> 4));
    f32x16 z16;
#pragma unroll
    for (int i = 0; i < 16; ++i) z16[i] = 0.f;
    LAS unsigned char* Hs = L + wave * 8704;
    const size_t loff = (size_t)(lane & 31) * SW + 16 * g + 8 * (lane >> 5);
    float hr = 0.f, hi = 0.f;
    if (nr > 0 && s0 > 0) {
        float pr = 1.f, pi = 0.f, br = lr, bi = li;
        for (int e = 64 * cps; e; e >>= 1) { if (e & 1) { const float tr = pr * br - pi * bi, ti = pr * bi + pi * br; pr = tr; pi = ti; } const float tr = br * br - bi * bi, ti = 2.f * br * bi; br = tr; bi = ti; }
        const f32x2* ep = (const f32x2*)(ws + WS_E) + g * 64 + lane;
        f32x2 ev[15];
#pragma unroll
        for (int sp = 0; sp < 15; ++sp) ev[sp] = (sp < s0) ? ldc_f2(ep + (size_t)sp * (NG * NP)) : (f32x2){0.f, 0.f};
#pragma unroll
        for (int sp = 0; sp < 15; ++sp) if (sp < s0) { const float tr = pr * hr - pi * hi + ev[sp].x, ti = pr * hi + pi * hr + ev[sp].y; hr = tr; hi = ti; }
        for (int sp = 15; sp < s0; ++sp) { const f32x2 e = ldc_f2(ep + (size_t)sp * (NG * NP)); const float tr = pr * hr - pi * hi + e.x, ti = pr * hi + pi * hr + e.y; hr = tr; hi = ti; }
    }
    bf16x8 a0, a1;
    u32x2 uwp[2][2];
    const size_t uoff = (size_t)(lane & 15) * SW + 16 * g + 4 * (lane >> 4);
    { const int r0 = s5_row0(0, nr, kb, s0, ns); const bf16* up = U + (size_t)r0 * SW + loff; a0 = *(const bf16x8*)up; a1 = *(const bf16x8*)(up + (size_t)32 * SW);
#pragma unroll
      for (int q = 0; q < 4; ++q) uwp[q >> 1][q & 1] = *(const u32x2*)(U + (size_t)(r0 + 16 * q) * SW + uoff); }
    for (int it = 0; it < cnt; ++it) {
        const int row0 = s5_row0(it, nr, kb, s0, ns);
        bf16x8 n0 = a0, n1 = a1;
        u32x2 uwn[2][2];
#pragma unroll
        for (int q = 0; q < 4; ++q) uwn[q >> 1][q & 1] = uwp[q >> 1][q & 1];
        if (it + 1 < cnt) { const int r1 = s5_row0(it + 1, nr, kb, s0, ns); const bf16* up = U + (size_t)r1 * SW + loff; n0 = *(const bf16x8*)up; n1 = *(const bf16x8*)(up + (size_t)32 * SW);
#pragma unroll
            for (int q = 0; q < 4; ++q) uwn[q >> 1][q & 1] = *(const u32x2*)(U + (size_t)(r1 + 16 * q) * SW + uoff); }
        float* ore; float* oim; bool last;
        if (it < nr) { last = (kb + it == NCHP - 1);
            ore = a.out + O_RE_P + (size_t)layer * NG * NP + g * 64 + lane; oim = a.out + O_IM_P + (size_t)layer * NG * NP + g * 64 + lane; }
        else { const int b = s0 + (it - nr) * ns; const size_t so = ((size_t)(layer * NSB + b) * NG + g) * NP + lane; hr = a.in[3][so]; hi = a.in[4][so]; asm volatile("" : "+v"(hr), "+v"(hi)); last = true;
            ore = a.out + O_RE_S + so; oim = a.out + O_IM_S + so; }
#pragma unroll
        for (int rt = 0; rt < 2; ++rt) {
            const bf16x8 af = rt ? a1 : a0;
            S5_BU(af)
#pragma unroll
            for (int aa = 0; aa < 4; ++aa)
#pragma unroll
                for (int h = 0; h < 2; ++h)
#pragma unroll
                    for (int i = 0; i < 4; ++i) { const int r = 4 * aa + i; const float tr = lr * hr - li * hi + bur[h][r], ti = lr * hi + li * hr + bui[h][r]; hr = tr; hi = ti;
                        *(LAS unsigned*)(Hs + (8 * aa + 4 * h + i) * 272 + 4 * lane) = cvt_pk_bf16(hr, hi); }
            LDS_WAIT();
#pragma unroll
            for (int m2 = 0; m2 < 2; ++m2) {
                f32x4 acc = {0.f, 0.f, 0.f, 0.f};
#pragma unroll
                for (int kk = 0; kk < 4; ++kk) { const bf16x8 hf = *(const LAS bf16x8*)(Hs + (16 * m2 + (lane & 15)) * 272 + 64 * kk + 16 * (lane >> 4)); acc = __builtin_amdgcn_mfma_f32_16x16x32_bf16(Cf[kk], hf, acc, 0, 0, 0); }
                const size_t row = (size_t)row0 + 32 * rt + 16 * m2 + (lane & 15);
                const u32x2 uw = uwp[rt][m2];
                const float y0 = acc[0] + dsk[0] * bflo(uw.x), y1 = acc[1] + dsk[1] * bfhi(uw.x), y2 = acc[2] + dsk[2] * bflo(uw.y), y3 = acc[3] + dsk[3] * bfhi(uw.y);
                const float g0 = y0 * sigmoidf_(1.5957691216f * (y0 + 0.044715f * y0 * y0 * y0)), g1 = y1 * sigmoidf_(1.5957691216f * (y1 + 0.044715f * y1 * y1 * y1));
                const float g2 = y2 * sigmoidf_(1.5957691216f * (y2 + 0.044715f * y2 * y2 * y2)), g3 = y3 * sigmoidf_(1.5957691216f * (y3 + 0.044715f * y3 * y3 * y3));
                u32x2 ow; ow.x = cvt_pk_bf16(g0, g1); ow.y = cvt_pk_bf16(g2, g3);
                *(u32x2*)(Gb + row * SW + 16 * g + 4 * (lane >> 4)) = ow;
            }
            LDS_WAIT();
        }
        if (last) { *ore = hr; *oim = hi; }
        a0 = n0; a1 = n1;
#pragma unroll
        for (int q = 0; q < 4; ++q) uwp[q >> 1][q & 1] = uwn[q >> 1][q & 1];
    }
}
__device__ __forceinline__ void mix_fix(const Args& a, int layer) {
    int t_ = threadIdx.x; asm volatile("" : "+v"(t_)); const int tid = t_;
    size_t wz_ = 0; asm volatile("" : "+s"(wz_)); unsigned char* ws = a.ws + wz_;
    const int gtid = blockIdx.x * 512 + tid, NT = gridDim.x * 512;
    const float* side = (const float*)(ws + WS_BIG + BIG_SIDE2); bf16* mix = (bf16*)(ws + WS_BIG + BIG_MIX);
    constexpr int NCG = CW / 4, NBLK = M / 64;
    for (int it = gtid; it < NBLK * NCG; it += NT) {
        const int blk = it / NCG, c0 = (it - blk * NCG) * 4;
        const float* cw = a.in[7] + (size_t)layer * 3 * CW + c0;
        f32x4 w0 = *(const f32x4*)cw, w1 = *(const f32x4*)(cw + CW), w2 = *(const f32x4*)(cw + 2 * CW);
        const float* sb = side + (size_t)blk * 6 * CW + c0;
        f32x4 z0 = *(const f32x4*)(sb + 2 * CW), z1 = *(const f32x4*)(sb + 3 * CW), b0 = *(const f32x4*)(sb + 4 * CW), b1 = *(const f32x4*)(sb + 5 * CW);
        f32x4 p0 = {0.f, 0.f, 0.f, 0.f}, p1 = p0;
        if (blk >= NCHP) { const float* sc = a.in[2] + ((size_t)(layer * NSB + (blk - NCHP)) * 2) * CW + c0; p0 = *(const f32x4*)sc; p1 = *(const f32x4*)(sc + CW); }
        else if (blk != 0) { const float* sp = side + (size_t)(blk - 1) * 6 * CW + c0; p0 = *(const f32x4*)sp; p1 = *(const f32x4*)(sp + CW); }
        asm volatile("" : "+v"(w0), "+v"(w1), "+v"(w2), "+v"(z0), "+v"(z1), "+v"(b0), "+v"(b1), "+v"(p0), "+v"(p1));
        const f32x4 y0 = b0 * (w0 * p0 + w1 * p1 + w2 * z0), y1 = b1 * (w0 * p1 + w1 * z0 + w2 * z1);
        u32x2 o0, o1; o0.x = cvt_pk_bf16(y0[0], y0[1]); o0.y = cvt_pk_bf16(y0[2], y0[3]); o1.x = cvt_pk_bf16(y1[0], y1[1]); o1.y = cvt_pk_bf16(y1[2], y1[3]);
        *(u32x2*)(mix + (size_t)(blk * 64) * D + c0) = o0; *(u32x2*)(mix + (size_t)(blk * 64 + 1) * D + c0) = o1;
        if (blk >= NCHP - 1) {
            float* o = (blk == NCHP - 1) ? a.out + O_CONV_P + (size_t)layer * 2 * CW + c0 : a.out + O_CONV_S + ((size_t)(layer * NSB + (blk - NCHP)) * 2) * CW + c0;
            *(f32x4*)o = *(const f32x4*)sb; *(f32x4*)(o + CW) = *(const f32x4*)(sb + CW);
        }
    }
}
__device__ __forceinline__ void ffn_fix(const Args& a, int layer) {
    int t_ = threadIdx.x; asm volatile("" : "+v"(t_)); const int tid = t_;
    size_t wz_ = 0; asm volatile("" : "+s"(wz_)); unsigned char* ws = a.ws + wz_;
    const int gtid = blockIdx.x * 512 + tid, NT = gridDim.x * 512;
    const bf16* side = (const bf16*)(ws + WS_BIG + BIG_SIDE); bf16* HG = (bf16*)(ws + WS_BIG + BIG_V);
    constexpr int NCG = DFF / 8, NBLK = M / 64;
    for (int it = gtid; it < NBLK * NCG; it += NT) {
        const int blk = it / NCG, cg = it - blk * NCG, c0 = cg * 8;
        float p0[8], p1[8], a0[8], a1[8], v0[8], v1[8], w0[8], w1[8], w2[8];
        const float* cw = a.in[22] + (size_t)layer * 3 * DFF + c0;
        f32x4 x0 = *(const f32x4*)cw, x1 = *(const f32x4*)(cw + 4), y0 = *(const f32x4*)(cw + DFF), y1 = *(const f32x4*)(cw + DFF + 4), z0 = *(const f32x4*)(cw + 2 * DFF), z1 = *(const f32x4*)(cw + 2 * DFF + 4);
        const bf16* sb = side + (size_t)blk * 6 * DFF + c0;
        u32x4 qa0 = *(const u32x4*)(sb + 2 * DFF), qa1 = *(const u32x4*)(sb + 3 * DFF), qv0 = *(const u32x4*)(sb + 4 * DFF), qv1 = *(const u32x4*)(sb + 5 * DFF);
        u32x4 q0 = {0u, 0u, 0u, 0u}, q1 = {0u, 0u, 0u, 0u};
        f32x4 s0 = {0.f, 0.f, 0.f, 0.f}, s1 = s0, s2 = s0, s3 = s0;
        if (blk >= NCHP) { const float* sc = a.in[5] + ((size_t)(layer * NSB + (blk - NCHP)) * 2) * DFF + c0; s0 = *(const f32x4*)sc; s1 = *(const f32x4*)(sc + 4); s2 = *(const f32x4*)(sc + DFF); s3 = *(const f32x4*)(sc + DFF + 4); }
        else if (blk != 0) { q0 = *(const u32x4*)(side + ((size_t)(blk - 1) * 6 + 0) * DFF + c0); q1 = *(const u32x4*)(side + ((size_t)(blk - 1) * 6 + 1) * DFF + c0); }
        asm volatile("" : "+v"(x0), "+v"(x1), "+v"(y0), "+v"(y1), "+v"(z0), "+v"(z1), "+v"(qa0), "+v"(qa1), "+v"(qv0), "+v"(qv1), "+v"(q0), "+v"(q1), "+v"(s0), "+v"(s1), "+v"(s2), "+v"(s3));
#pragma unroll
        for (int j = 0; j < 4; ++j) { w0[j] = x0[j]; w0[4 + j] = x1[j]; w1[j] = y0[j]; w1[4 + j] = y1[j]; w2[j] = z0[j]; w2[4 + j] = z1[j]; }
        if (blk >= NCHP) {
#pragma unroll
            for (int j = 0; j < 4; ++j) { p0[j] = s0[j]; p0[4 + j] = s1[j]; p1[j] = s2[j]; p1[4 + j] = s3[j]; }
        } else {
#pragma unroll
            for (int j = 0; j < 4; ++j) { p0[2 * j] = bflo(q0[j]); p0[2 * j + 1] = bfhi(q0[j]); p1[2 * j] = bflo(q1[j]); p1[2 * j + 1] = bfhi(q1[j]); }
        }
#pragma unroll
        for (int j = 0; j < 4; ++j) { a0[2 * j] = bflo(qa0[j]); a0[2 * j + 1] = bfhi(qa0[j]); a1[2 * j] = bflo(qa1[j]); a1[2 * j + 1] = bfhi(qa1[j]);
            v0[2 * j] = bflo(qv0[j]); v0[2 * j + 1] = bfhi(qv0[j]); v1[2 * j] = bflo(qv1[j]); v1[2 * j + 1] = bfhi(qv1[j]); }
        float h0[8], h1[8];
#pragma unroll
        for (int j = 0; j < 8; ++j) { const float c0v = w0[j] * p0[j] + w1[j] * p1[j] + w2[j] * a0[j], c1v = w0[j] * p1[j] + w1[j] * a0[j] + w2[j] * a1[j];
            h0[j] = c0v * sigmoidf_(c0v) * v0[j]; h1[j] = c1v * sigmoidf_(c1v) * v1[j]; }
        u32x4 o0, o1; o0.x = cvt_pk_bf16(h0[0], h0[1]); o0.y = cvt_pk_bf16(h0[2], h0[3]); o0.z = cvt_pk_bf16(h0[4], h0[5]); o0.w = cvt_pk_bf16(h0[6], h0[7]);
        o1.x = cvt_pk_bf16(h1[0], h1[1]); o1.y = cvt_pk_bf16(h1[2], h1[3]); o1.z = cvt_pk_bf16(h1[4], h1[5]); o1.w = cvt_pk_bf16(h1[6], h1[7]);
        *(u32x4*)(HG + (size_t)(blk * 64) * DFF + c0) = o0; *(u32x4*)(HG + (size_t)(blk * 64 + 1) * DFF + c0) = o1;
        if (blk >= NCHP - 1) {
            const u32x4 q0 = *(const u32x4*)(side + ((size_t)blk * 6 + 0) * DFF + c0), q1 = *(const u32x4*)(side + ((size_t)blk * 6 + 1) * DFF + c0);
            float* o = (blk == NCHP - 1) ? a.out + O_FFN_P + (size_t)layer * 2 * DFF + c0 : a.out + O_FFN_S + ((size_t)(layer * NSB + (blk - NCHP)) * 2) * DFF + c0;
            *(f32x4*)o = (f32x4){bflo(q0[0]), bfhi(q0[0]), bflo(q0[1]), bfhi(q0[1])}; *(f32x4*)(o + 4) = (f32x4){bflo(q0[2]), bfhi(q0[2]), bflo(q0[3]), bfhi(q0[3])};
            *(f32x4*)(o + DFF) = (f32x4){bflo(q1[0]), bfhi(q1[0]), bflo(q1[1]), bfhi(q1[1])}; *(f32x4*)(o + DFF + 4) = (f32x4){bflo(q1[2]), bfhi(q1[2]), bflo(q1[3]), bfhi(q1[3])};
        }
    }
}
__device__ __forceinline__ float wave_sum(float v) {
#pragma unroll
    for (int o = 1; o < 64; o <<= 1) v += __shfl_xor(v, o);
    return v;
}
__device__ __forceinline__ void ln_rows(const bf16* __restrict__ R, const float* __restrict__ gam, const float* __restrict__ bet, float* OF, bf16* OB, const float* slabs, const float* resB, const bf16* resBh, LAS unsigned char* L) {
    int t_ = threadIdx.x; asm volatile("" : "+v"(t_)); const int tid = t_, lane = tid & 63, wave = __builtin_amdgcn_readfirstlane(tid >> 6); (void)lane; (void)wave;
    const int gw = blockIdx.x * 8 + wave, NGW = gridDim.x * 8;
    for (int q = tid; q < D / 4; q += 512) { const int j = q >> 7, ln = (q & 127) >> 1, h = q & 1; LAS unsigned char* gl = L + j * 16384 + 8704 + (h * 64 + ln) * 16;
        *(LAS f32x4*)gl = ((const f32x4*)gam)[q]; *(LAS f32x4*)(gl + 2048) = ((const f32x4*)bet)[q]; }
    __syncthreads();
    const bool bal = (slabs != nullptr) && (NGW > 2 * (M - TP));
    const int m_first = bal ? (gw < M - TP ? TP + gw : gw - (M - TP)) : gw, m_step = bal ? (gw < M - TP ? M : NGW - (M - TP)) : NGW, m_end = bal ? (gw < M - TP ? M : TP) : M;
    u32x4 cx[8];
#pragma unroll
    for (int j = 0; j < 8; ++j) cx[j] = (u32x4){0u, 0u, 0u, 0u};
    if (m_first < m_end && !(slabs != nullptr && m_first >= TP)) { const u32x4* xr = (const u32x4*)(R + (size_t)m_first * D) + lane;
#pragma unroll
        for (int j = 0; j < 8; ++j) cx[j] = xr[64 * j]; }
    for (int m = m_first; m < m_end; m += m_step) {
        const int mn = m + m_step; const bool pre = (mn < m_end) && !(slabs != nullptr && mn >= TP);
        u32x4 nx[8];
#pragma unroll
        for (int j = 0; j < 8; ++j) nx[j] = cx[j];
        if (pre) { const u32x4* xr = (const u32x4*)(R + (size_t)mn * D) + lane;
#pragma unroll
            for (int j = 0; j < 8; ++j) nx[j] = xr[64 * j]; }
        f32x4 v[8][2]; float s = 0.f;
        if (slabs != nullptr && m >= TP) {
#define LN_PIN16(t) asm volatile("" : "+v"(t[0][0]), "+v"(t[0][1]), "+v"(t[1][0]), "+v"(t[1][1]), "+v"(t[2][0]), "+v"(t[2][1]), "+v"(t[3][0]), "+v"(t[3][1]), "+v"(t[4][0]), "+v"(t[4][1]), "+v"(t[5][0]), "+v"(t[5][1]), "+v"(t[6][0]), "+v"(t[6][1]), "+v"(t[7][0]), "+v"(t[7][1]))
            if (resBh != nullptr) { const u32x4* rh = (const u32x4*)(resBh + (size_t)(m - TP) * D) + lane;
                u32x4 hq[8];
#pragma unroll
                for (int j = 0; j < 8; ++j) hq[j] = rh[64 * j];
                asm volatile("" : "+v"(hq[0]), "+v"(hq[1]), "+v"(hq[2]), "+v"(hq[3]), "+v"(hq[4]), "+v"(hq[5]), "+v"(hq[6]), "+v"(hq[7]));
#pragma unroll
                for (int j = 0; j < 8; ++j) { const u32x4 hv = hq[j]; v[j][0] = (f32x4){bflo(hv.x), bfhi(hv.x), bflo(hv.y), bfhi(hv.y)} * ALPHA; v[j][1] = (f32x4){bflo(hv.z), bfhi(hv.z), bflo(hv.w), bfhi(hv.w)} * ALPHA; } }
            else { const f32x4* rr = (const f32x4*)(resB + (size_t)(m - TP) * D) + 2 * lane;
                f32x4 t[8][2];
#pragma unroll
                for (int j = 0; j < 8; ++j) { t[j][0] = rr[128 * j]; t[j][1] = rr[128 * j + 1]; }
                LN_PIN16(t);
#pragma unroll
                for (int j = 0; j < 8; ++j) { v[j][0] = t[j][0] * ALPHA; v[j][1] = t[j][1] * ALPHA; } }
            for (int sp = 0; sp < 8; ++sp) { const f32x4* sr = (const f32x4*)(slabs + ((size_t)sp * (M - TP) + (m - TP)) * D) + 2 * lane;
                f32x4 t[8][2];
#pragma unroll
                for (int j = 0; j < 8; ++j) { t[j][0] = sr[128 * j]; t[j][1] = sr[128 * j + 1]; }
                LN_PIN16(t);
#pragma unroll
                for (int j = 0; j < 8; ++j) { v[j][0] += t[j][0]; v[j][1] += t[j][1]; } }
#undef LN_PIN16
        } else {
#pragma unroll
            for (int j = 0; j < 8; ++j) { const u32x4 hv = cx[j]; v[j][0] = (f32x4){bflo(hv.x), bfhi(hv.x), bflo(hv.y), bfhi(hv.y)}; v[j][1] = (f32x4){bflo(hv.z), bfhi(hv.z), bflo(hv.w), bfhi(hv.w)}; }
        }
#pragma unroll
        for (int j = 0; j < 8; ++j)
#pragma unroll
            for (int h = 0; h < 2; ++h) s += (v[j][h][0] + v[j][h][1]) + (v[j][h][2] + v[j][h][3]);
        const float mean = wave_sum(s) * (1.f / D); float s2 = 0.f;
#pragma unroll
        for (int j = 0; j < 8; ++j)
#pragma unroll
            for (int h = 0; h < 2; ++h) { v[j][h] = v[j][h] - mean; s2 += (v[j][h][0] * v[j][h][0] + v[j][h][1] * v[j][h][1]) + (v[j][h][2] * v[j][h][2] + v[j][h][3] * v[j][h][3]); }
        const float rstd = 1.f / sqrtf(wave_sum(s2) * (1.f / D) + LN_EPS);
#pragma unroll
        for (int j = 0; j < 8; ++j) {
            const LAS f32x4* gl = (const LAS f32x4*)(L + j * 16384 + 8704) + lane;
            const f32x4 o0 = v[j][0] * rstd * gl[0] + gl[128], o1 = v[j][1] * rstd * gl[64] + gl[192];
            if (OF) { f32x4* op = (f32x4*)(OF + (size_t)m * D) + 128 * j + 2 * lane; op[0] = o0; op[1] = o1; }
            if (OB) { u32x4 w; w.x = cvt_pk_bf16(o0[0], o0[1]); w.y = cvt_pk_bf16(o0[2], o0[3]); w.z = cvt_pk_bf16(o1[0], o1[1]); w.w = cvt_pk_bf16(o1[2], o1[3]); ((u32x4*)(OB + (size_t)m * D))[lane + 64 * j] = w; }
        }
#pragma unroll
        for (int j = 0; j < 8; ++j) cx[j] = nx[j];
    }
}

__global__ void __launch_bounds__(512, 2) fwd(Args args) {
    extern __shared__ __attribute__((aligned(16))) unsigned char lds[];
    LAS unsigned char* L = (LAS unsigned char*)lds;
    const int tid = threadIdx.x;
    const int G = gridDim.x;
    unsigned char* ws = args.ws;
    for (int u = tid; u < (LDS_BYTES - LDSCTL_OFF) / 4; u += 512) ((LAS unsigned*)(L + LDSCTL_OFF))[u] = 0u;
    __syncthreads();
    const int lo = args.ph_lo, hi = args.ph_hi;
    const bool use_bar = (hi - lo) > 1;
    XcdBarrier bar; bar.bar = (unsigned*)(ws + WS_CTL) + CW_BAR; bar.x = 0; bar.st = (volatile LAS unsigned*)(L + LDSCTL_OFF);
    if (use_bar) bar = xcd_barrier_post((unsigned*)(ws + WS_CTL) + CW_BAR, (volatile LAS unsigned*)(L + LDSCTL_OFF));
#define IN(k) (lo <= (k) && (k) < hi)
#define SEAM(k) do { if (IN(k) && IN((k) + 1)) xcd_barrier(bar); } while (0)

    for (int layer = 0; layer < 2; ++layer) {
        const int pb = layer * NPH;
        const bool split_ok = (G == 256);
        const bool wsec = false, tails = (G == 256);
        if (layer == 0) { if (IN(pb + 0)) { phase0(args, 0, L); } SEAM(pb + 0); }
        if (IN(pb + 1)) {
            unsigned char* ws = args.ws; asm volatile("" : "+s"(ws));
            pg8::Gemm g{(const bf16*)(ws + WS_XB), (const bf16*)(ws + w_off(0, wsec)), M, NPROJ, D}; pg8::TwoPartOrder S; S.init(M, TP, NPROJ, G, (int)blockIdx.x, D);
            pg8::EpiMix E{(bf16*)(ws + WS_BIG + BIG_MIX), D, (bf16*)(ws + WS_BIG + BIG_U), SW, args.in[7] + (size_t)layer * 3 * CW, CW, (float*)(ws + WS_BIG + BIG_SIDE2)};
            pg8::gemm_phase<pg8::EpiMix, pg8::TwoPartOrder, true, true>(L, g, S, E);
            if (tails) tail_convert(args, layer, L, S.nwg % G, CV_IN, CV_G1);
        } SEAM(pb + 1);
        if (IN(pb + 2)) { s5_pass_a(ws); mix_fix(args, layer); } SEAM(pb + 2);
        if (IN(pb + 3)) { s5_pass_c(args, layer, L); } SEAM(pb + 3);
        if (IN(pb + 4)) {
            unsigned char* ws = args.ws; asm volatile("" : "+s"(ws));
            pg8::Gemm g{(const bf16*)(ws + WS_BIG + BIG_G), (const bf16*)(ws + w_off(1, wsec)), M, SW, SW}; pg8::TwoPartOrder S; S.init(M, TP, SW, G, (int)blockIdx.x, SW);
            pg8::EpiGlu E{(const bf16*)(ws + WS_BIG + BIG_G), SW, (bf16*)(ws + WS_BIG + BIG_MIX), D, CW};
            pg8::gemm_phase<pg8::EpiGlu, pg8::TwoPartOrder, true, true>(L, g, S, E);
            if (tails) tail_convert(args, layer, L, S.nwg % G, CV_G1, CV_G2);
        } SEAM(pb + 4);
        if (IN(pb + 5)) {
            unsigned char* ws = args.ws; asm volatile("" : "+s"(ws));
            pg8::Gemm g{(const bf16*)(ws + WS_BIG + BIG_MIX), (const bf16*)(ws + w_off(2, wsec)), M, D, D}; pg8::SplitOrder S; S.init(M, TP, D, G, (int)blockIdx.x, D);
            pg8::EpiRes E{args.in[0], args.in[1], layer == 0 ? (const bf16*)nullptr : (const bf16*)(ws + WS_XB), TP, (bf16*)(ws + WS_BIG + BIG_R), D, ALPHA, (float*)(ws + WS_BIG + BIG_SLAB1), (size_t)(M - TP) * D};
            pg8::gemm_phase<pg8::EpiRes, pg8::SplitOrder, true, true>(L, g, S, E);
        } SEAM(pb + 5);
        if (IN(pb + 6)) { ln_rows((const bf16*)(ws + WS_BIG + BIG_R), args.in[18] + (size_t)layer * D, args.in[19] + (size_t)layer * D, (float*)nullptr, (bf16*)(ws + WS_XB), split_ok ? (const float*)(ws + WS_BIG + BIG_SLAB1) : (const float*)nullptr, args.in[1], layer == 0 ? (const bf16*)nullptr : (const bf16*)(ws + WS_XB) + (size_t)TP * D, L); if (tails) all_convert(args, layer, L, CV_G2, CV_AV); } SEAM(pb + 6);
        if (IN(pb + 7)) {
            unsigned char* ws = args.ws; asm volatile("" : "+s"(ws));
            pg8::Gemm g{(const bf16*)(ws + WS_XB), (const bf16*)(ws + w_off(3, wsec)), M, NAV, D}; pg8::TwoPartOrder S; S.init(M, TP, NAV, G, (int)blockIdx.x, D);
            pg8::EpiGate E{(bf16*)(ws + WS_BIG + BIG_V), DFF, args.in[22] + (size_t)layer * 3 * DFF, (bf16*)(ws + WS_BIG + BIG_SIDE)};
            pg8::gemm_phase<pg8::EpiGate, pg8::TwoPartOrder, true, true>(L, g, S, E);
            if (tails) { tail_convert(args, layer, L, S.nwg % G, CV_AV, CV_ALL); if (layer == 0) tail_convert(args, 1, L, S.nwg % G, 0, CV_NEXT); }
        } SEAM(pb + 7);
        if (IN(pb + 8)) { ffn_fix(args, layer); } SEAM(pb + 8);
        if (IN(pb + 9)) {
            unsigned char* ws = args.ws; asm volatile("" : "+s"(ws));
            pg8::Gemm g{(const bf16*)(ws + WS_BIG + BIG_V), (const bf16*)(ws + w_off(4, wsec)), M, D, DFF}; pg8::SplitOrder S; S.init(M, TP, D, G, (int)blockIdx.x, DFF); S.full.wgm = 2; S.all.wgm = 2;
            pg8::EpiRes E{nullptr, nullptr, (const bf16*)(ws + WS_XB), TP, (bf16*)(ws + WS_BIG + BIG_R), D, ALPHA, (float*)(ws + WS_BIG + BIG_SLAB2), (size_t)(M - TP) * D};
            pg8::gemm_phase<pg8::EpiRes, pg8::SplitOrder, true, true>(L, g, S, E);
        } SEAM(pb + 9);
        if (IN(pb + 10)) {
            ln_rows((const bf16*)(ws + WS_BIG + BIG_R), args.in[24] + (size_t)layer * D, args.in[25] + (size_t)layer * D,
                    layer == 0 ? (float*)nullptr : args.out + O_Y, layer == 0 ? (bf16*)(ws + WS_XB) : (bf16*)nullptr, split_ok ? (const float*)(ws + WS_BIG + BIG_SLAB2) : (const float*)nullptr, (const float*)nullptr, (const bf16*)(ws + WS_XB) + (size_t)TP * D, L);
            if (layer == 0) phase0(args, 1, L);
        } SEAM(pb + 10);
    }
#undef IN
#undef SEAM
}

#ifndef MK_ONE_LAUNCH
#define MK_ONE_LAUNCH 1
#endif
extern "C" void kernel_launch(void* const* d_in, const int* in_sizes, int n_in, void* d_out, int out_size, void* d_ws, size_t ws_size, hipStream_t stream) {
    static int grid = 0;
    if (grid == 0) {
        if (n_in != 26 || in_sizes[0] != TP * D || (size_t)out_size != OUT_TOTAL || ws_size < WS_END) {   fprintf(stderr, "kernel_launch: unexpected shapes (n_in %d, in0 %d, out %d, ws %zu)\n", n_in, n_in > 0 ? in_sizes[0] : -1, out_size, ws_size); grid = -1; return; }
        int dev = 0, cus = 0, per_cu = 0;
        if (hipGetDevice(&dev) != hipSuccess || hipDeviceGetAttribute(&cus, hipDeviceAttributeMultiprocessorCount, dev) != hipSuccess) { grid = -1; return; }
        if (hipFuncSetAttribute((const void*)fwd, hipFuncAttributeMaxDynamicSharedMemorySize, LDS_BYTES) != hipSuccess) { fprintf(stderr, "kernel_launch: hipFuncSetAttribute failed\n"); grid = -1; return; }
        if (hipOccupancyMaxActiveBlocksPerMultiprocessor(&per_cu, (const void*)fwd, 512, LDS_BYTES) != hipSuccess || per_cu < 1) { fprintf(stderr, "kernel_launch: occupancy query says %d\n", per_cu); (void)hipGetLastError(); grid = -1; return; }
        grid = cus;
    }
    if (grid < 0) return;
    if (hipMemsetAsync((char*)d_ws + WS_CTL, 0, CTL_ZERO_BYTES, stream) != hipSuccess) return;
    Args a{};
    for (int i = 0; i < 26; ++i) a.in[i] = (const float*)d_in[i];
    a.out = (float*)d_out; a.ws = (unsigned char*)d_ws; a.w2 = 0; a.pad = 0;
#if MK_ONE_LAUNCH
    a.ph_lo = 0; a.ph_hi = 2 * NPH;
    hipLaunchKernelGGL(fwd, dim3(grid), dim3(512), LDS_BYTES, stream, a);
#else
#ifndef PROBE_MASK
#define PROBE_MASK 0
#endif
#ifndef PROBE_REPS
#define PROBE_REPS 1
#endif
    for (int ph = 0; ph < 2 * NPH; ++ph) { const int reps = ((PROBE_MASK >> (ph % NPH)) & 1) ? PROBE_REPS : 1;
        for (int r = 0; r < reps; ++r) { a.ph_lo = ph; a.ph_hi = ph + 1; hipLaunchKernelGGL(fwd, dim3(grid), dim3(512), LDS_BYTES, stream, a); } }
#endif
}
```
